# Optimizing an MI355X kernel written in HIP

```python
import math
import jax, jax.numpy as jnp
from jax import lax
import numpy as np


D_MODEL = 2048
BATCH = 32
SEQ = 256
DEPTH = 2
DEC_BATCH = 8
DEC_SEQ = 1024
PAST_LEN = 512

GRID_W = 64
Q_BLOCK = 128
ROPE_BASE = 10000.0
EPS = 1e-6
SSM_CH = 512
SSM_GROUP = 16
SSM_GROUPS = SSM_CH // SSM_GROUP
SSM_STATE = 64
GQA_HEADS = 6
GQA_KV_HEADS = 2
GQA_GROUP = GQA_HEADS // GQA_KV_HEADS
GQA_HEAD_DIM = 128
MLA_HEADS = 6
MLA_NOPE = 128
MLA_ROPE = 64
MLA_QK = MLA_NOPE + MLA_ROPE
MLA_V = 128
MLA_KV_RANK = 512
D_FF = 4 * D_MODEL
A_U_W = SSM_CH
B_Q_W = GQA_HEADS * GQA_HEAD_DIM
B_KV_W = GQA_KV_HEADS * GQA_HEAD_DIM
C_Q_W = MLA_HEADS * MLA_QK
IN_SPLITS = (A_U_W, A_U_W + B_Q_W, A_U_W + B_Q_W + B_KV_W, A_U_W + B_Q_W + 2 * B_KV_W, A_U_W + B_Q_W + 2 * B_KV_W + C_Q_W, A_U_W + B_Q_W + 2 * B_KV_W + C_Q_W + MLA_KV_RANK)
IN_WIDTH = IN_SPLITS[-1] + MLA_ROPE
MIX_WIDTH = SSM_CH + GQA_HEADS * GQA_HEAD_DIM + MLA_HEADS * MLA_V

kernel_name = 'hybrid_s5_gqa_mla_prefix_dit_step'


def rms_norm(x, g):
    xf = x.astype(jnp.float32)
    y = xf * lax.rsqrt(jnp.mean(xf * xf, axis=-1, keepdims=True) + EPS)
    return (y * g.astype(jnp.float32)).astype(x.dtype)


def modulate(h, shift, scale):
    return h * (1.0 + scale) + shift


def adaln(cvec, w, b):
    m = (jax.nn.silu(cvec) @ w + b)[:, None, :]
    return jnp.split(m, 6, axis=-1)


def axial_rope(x):
    t, d = x.shape[1], x.shape[-1]
    rows = t // GRID_W
    half = d // 2
    quarter = half // 2
    row = jnp.repeat(jnp.arange(rows, dtype=jnp.float32), GRID_W)
    col = jnp.tile(jnp.arange(GRID_W, dtype=jnp.float32), rows)
    inv = ROPE_BASE ** (-(jnp.arange(quarter, dtype=jnp.float32) / quarter))
    xf = x.astype(jnp.float32)

    def rotate(xa, pos):
        ang = pos[:, None] * inv[None, :]
        cos = jnp.cos(ang)[None, :, None, :]
        sin = jnp.sin(ang)[None, :, None, :]
        x1, x2 = xa[..., :quarter], xa[..., quarter:]
        return jnp.concatenate([x1 * cos - x2 * sin, x2 * cos + x1 * sin], axis=-1)

    out = jnp.concatenate([rotate(xf[..., :half], row), rotate(xf[..., half:], col)], axis=-1)
    return out.astype(x.dtype)


def rope_tail(x):
    return jnp.concatenate([x[..., :MLA_NOPE], axial_rope(x[..., MLA_NOPE:])], axis=-1)


def blocked_attention(q, k, v):
    bsz, s = q.shape[0], q.shape[1]
    nb = s // Q_BLOCK
    scale = 1.0 / math.sqrt(q.shape[-1])
    kf = k.astype(jnp.float32)
    vf = v.astype(jnp.float32)
    qb = q.reshape((bsz, nb, Q_BLOCK) + q.shape[2:]).swapaxes(0, 1)

    def one_block(qblk):
        sc = jnp.einsum('bqhgd,bkhd->bhgqk', qblk.astype(jnp.float32), kf) * scale
        pr = jax.nn.softmax(sc, axis=-1)
        return jnp.einsum('bhgqk,bkhd->bqhgd', pr, vf).astype(q.dtype)

    out = lax.map(one_block, qb)
    return out.swapaxes(0, 1).reshape((bsz, s) + out.shape[3:])


def linear_scan(lam_bar, bu, h0, reverse):
    if h0 is not None:
        edge = bu.shape[1] - 1 if reverse else 0
        bu = bu.at[:, edge].add(lam_bar[None] * h0)
    a = jnp.broadcast_to(lam_bar, bu.shape)

    def combine(e1, e2):
        a1, b1 = e1
        a2, b2 = e2
        return a1 * a2, a2 * b1 + b2

    _, states = lax.associative_scan(combine, (a, bu), reverse=reverse, axis=1)
    return states


def s5_bidirectional(u, lam_re, lam_im, log_dt, b_re, b_im, c_re, c_im, d_skip, w_glu, h0_f, h0_b):
    bsz, t = u.shape[0], u.shape[1]
    uf = u.astype(jnp.float32).reshape(bsz, t, SSM_GROUPS, SSM_GROUP)
    uc = uf.astype(jnp.complex64)
    y = d_skip.astype(jnp.float32).reshape(SSM_GROUPS, SSM_GROUP) * uf
    finals = []
    for dr, (h0, reverse) in enumerate(((h0_f, False), (h0_b, True))):
        lam = lax.complex(lam_re[dr].astype(jnp.float32), lam_im[dr].astype(jnp.float32))
        dt = jnp.exp(log_dt[dr].astype(jnp.float32))[:, None]
        lam_bar = jnp.exp(lam * dt)
        b_mat = lax.complex(b_re[dr].astype(jnp.float32), b_im[dr].astype(jnp.float32))
        b_bar = ((lam_bar - 1.0) / lam)[..., None] * b_mat
        bu = jnp.einsum('btgc,gpc->btgp', uc, b_bar)
        states = linear_scan(lam_bar, bu, h0, reverse)
        c_mat = lax.complex(c_re[dr].astype(jnp.float32), c_im[dr].astype(jnp.float32))
        y = y + jnp.real(jnp.einsum('gcp,btgp->btgc', c_mat, states))
        finals.append(states[:, 0] if reverse else states[:, -1])
    y = y.reshape(bsz, t, SSM_CH).astype(u.dtype)
    zg = y @ w_glu
    out = zg[..., :SSM_CH] * jax.nn.sigmoid(zg[..., SSM_CH:])
    return out, finals[0], finals[1]


def mla_expand(ckv_n, kr, w_uk, w_uv, k_norm):
    k_nope = jnp.einsum('btr,rhd->bthd', ckv_n, w_uk)
    v = jnp.einsum('btr,rhd->bthd', ckv_n, w_uv)
    k_rope = jnp.broadcast_to(kr[:, :, None, :], kr.shape[:2] + (MLA_HEADS, MLA_ROPE))
    k = rms_norm(jnp.concatenate([k_nope, k_rope], axis=-1), k_norm)
    return k, v


def trunk_layer(x, mod, p, ctx):
    latent = ctx is not None
    shift1, scale1, gate1, shift2, scale2, gate2 = mod
    bsz, t = x.shape[0], x.shape[1]
    h = modulate(rms_norm(x, p['norm_mix']), shift1, scale1)
    z = h @ p['w_in']
    u, qb, kb, vb, qc, ckv, kr = jnp.split(z, IN_SPLITS, axis=-1)

    if latent:
        s = ctx['ssm']
        h0 = lax.complex(s[..., 0].astype(jnp.float32), s[..., 1].astype(jnp.float32))
        h0_f, h0_b = h0[:, 0], h0[:, 1]
    else:
        h0_f, h0_b = None, None
    y_a, hf, hb = s5_bidirectional(u, p['ssm_lam_re'], p['ssm_lam_im'], p['ssm_log_dt'], p['ssm_b_re'], p['ssm_b_im'], p['ssm_c_re'], p['ssm_c_im'], p['ssm_d'], p['ssm_w_glu'], h0_f, h0_b)

    q = rms_norm(qb.reshape(bsz, t, GQA_HEADS, GQA_HEAD_DIM), p['gqa_q_norm'])
    k = rms_norm(kb.reshape(bsz, t, GQA_KV_HEADS, GQA_HEAD_DIM), p['gqa_k_norm'])
    v = vb.reshape(bsz, t, GQA_KV_HEADS, GQA_HEAD_DIM)
    if latent:
        q_b = axial_rope(q)
        k_b = jnp.concatenate([ctx['k'].astype(k.dtype), axial_rope(k)], axis=1)
        v_b = jnp.concatenate([ctx['v'].astype(v.dtype), v], axis=1)
    else:
        q_b, k_b, v_b = q, k, v
    y_b = blocked_attention(q_b.reshape(bsz, t, GQA_KV_HEADS, GQA_GROUP, GQA_HEAD_DIM), k_b, v_b)
    y_b = y_b.reshape(bsz, t, GQA_HEADS * GQA_HEAD_DIM)

    ckv_n = rms_norm(ckv, p['mla_kv_norm'])
    q_c = rms_norm(qc.reshape(bsz, t, MLA_HEADS, MLA_QK), p['mla_q_norm'])
    k_c, v_c = mla_expand(ckv_n, kr, p['mla_w_uk'], p['mla_w_uv'], p['mla_k_norm'])
    if latent:
        q_c = rope_tail(q_c)
        k_ctx, v_ctx = mla_expand(ctx['ckv'].astype(ckv_n.dtype), ctx['kr'].astype(kr.dtype), p['mla_w_uk'], p['mla_w_uv'], p['mla_k_norm'])
        k_c = jnp.concatenate([k_ctx, rope_tail(k_c)], axis=1)
        v_c = jnp.concatenate([v_ctx, v_c], axis=1)
    y_c = blocked_attention(q_c[:, :, :, None, :], k_c, v_c).reshape(bsz, t, MLA_HEADS * MLA_V)

    o = jnp.concatenate([y_a, y_b, y_c], axis=-1) @ p['w_out']
    x = x + gate1 * o
    h2 = modulate(rms_norm(x, p['norm_mlp']), shift2, scale2)
    x = x + gate2 * (jnp.square(jax.nn.relu(h2 @ p['w_ff1'])) @ p['w_ff2'])
    new_ctx = None if latent else (k, v, ckv_n, kr, hf, hb)
    return x, new_ctx


def setup_inputs(seed: int = 0) -> dict:
    key = jax.random.key(seed)
    ks = iter(jax.random.split(key, 48))
    f32 = jnp.float32

    def nrm(shape, scale):
        return scale * jax.random.normal(next(ks), shape, f32)

    def gain(shape):
        return 1.0 + 0.05 * jax.random.normal(next(ks), shape, f32)

    ssm_shape = (DEPTH, 2, SSM_GROUPS, SSM_STATE)
    return {
        'x_prompt': nrm((BATCH, SEQ, D_MODEL), 1.0),
        'x_sample': nrm((DEC_BATCH, DEC_SEQ, D_MODEL), 1.0),
        'cache_attn_k': nrm((DEC_BATCH, DEPTH, PAST_LEN, GQA_KV_HEADS, GQA_HEAD_DIM), 1.0),
        'cache_attn_v': nrm((DEC_BATCH, DEPTH, PAST_LEN, GQA_KV_HEADS, GQA_HEAD_DIM), 1.0),
        'cache_mla_ckv': nrm((DEC_BATCH, DEPTH, PAST_LEN, MLA_KV_RANK), 1.0),
        'cache_mla_krope': nrm((DEC_BATCH, DEPTH, PAST_LEN, MLA_ROPE), 1.0),
        'state_ssm': nrm((DEC_BATCH, DEPTH, 2, SSM_GROUPS, SSM_STATE, 2), 0.3),
        'c': nrm((DEC_BATCH, D_MODEL), 1.0),
        'c_ctx': nrm((D_MODEL,), 1.0),
        'w_mod': nrm((DEPTH, D_MODEL, 6 * D_MODEL), D_MODEL ** -0.5),
        'b_mod': nrm((DEPTH, 6 * D_MODEL), 0.02),
        'norm_mix': gain((DEPTH, D_MODEL)),
        'norm_mlp': gain((DEPTH, D_MODEL)),
        'w_in': nrm((DEPTH, D_MODEL, IN_WIDTH), D_MODEL ** -0.5),
        'gqa_q_norm': gain((DEPTH, GQA_HEAD_DIM)),
        'gqa_k_norm': gain((DEPTH, GQA_HEAD_DIM)),
        'mla_kv_norm': gain((DEPTH, MLA_KV_RANK)),
        'mla_q_norm': gain((DEPTH, MLA_QK)),
        'mla_k_norm': gain((DEPTH, MLA_QK)),
        'mla_w_uk': nrm((DEPTH, MLA_KV_RANK, MLA_HEADS, MLA_NOPE), MLA_KV_RANK ** -0.5),
        'mla_w_uv': nrm((DEPTH, MLA_KV_RANK, MLA_HEADS, MLA_V), MLA_KV_RANK ** -0.5),
        'ssm_lam_re': -0.5 * jnp.exp(nrm(ssm_shape, 0.02)),
        'ssm_lam_im': math.pi * jnp.arange(SSM_STATE, dtype=f32) + nrm(ssm_shape, 0.02),
        'ssm_log_dt': jax.random.uniform(next(ks), (DEPTH, 2, SSM_GROUPS), f32, math.log(1e-3), math.log(1e-1)),
        'ssm_b_re': nrm((DEPTH, 2, SSM_GROUPS, SSM_STATE, SSM_GROUP), SSM_GROUP ** -0.5),
        'ssm_b_im': nrm((DEPTH, 2, SSM_GROUPS, SSM_STATE, SSM_GROUP), SSM_GROUP ** -0.5),
        'ssm_c_re': nrm((DEPTH, 2, SSM_GROUPS, SSM_GROUP, SSM_STATE), SSM_STATE ** -0.5),
        'ssm_c_im': nrm((DEPTH, 2, SSM_GROUPS, SSM_GROUP, SSM_STATE), SSM_STATE ** -0.5),
        'ssm_d': nrm((DEPTH, SSM_CH), 1.0),
        'ssm_w_glu': nrm((DEPTH, SSM_CH, 2 * SSM_CH), SSM_CH ** -0.5),
        'w_out': nrm((DEPTH, MIX_WIDTH, D_MODEL), MIX_WIDTH ** -0.5),
        'w_ff1': nrm((DEPTH, D_MODEL, D_FF), D_MODEL ** -0.5),
        'w_ff2': nrm((DEPTH, D_FF, D_MODEL), D_FF ** -0.5),
    }


def reference(x_prompt, x_sample, cache_attn_k, cache_attn_v, cache_mla_ckv, cache_mla_krope, state_ssm, c, c_ctx, w_mod, b_mod, norm_mix, norm_mlp, w_in, gqa_q_norm, gqa_k_norm, mla_kv_norm, mla_q_norm, mla_k_norm, mla_w_uk, mla_w_uv, ssm_lam_re, ssm_lam_im, ssm_log_dt, ssm_b_re, ssm_b_im, ssm_c_re, ssm_c_im, ssm_d, ssm_w_glu, w_out, w_ff1, w_ff2):
    xp = x_prompt
    xs = x_sample
    new_k, new_v, new_ckv, new_kr, new_ssm = [], [], [], [], []
    for l in range(DEPTH):
        p = {
            'norm_mix': norm_mix[l], 'norm_mlp': norm_mlp[l], 'w_in': w_in[l], 'w_out': w_out[l],
            'w_ff1': w_ff1[l], 'w_ff2': w_ff2[l],
            'gqa_q_norm': gqa_q_norm[l], 'gqa_k_norm': gqa_k_norm[l],
            'mla_kv_norm': mla_kv_norm[l], 'mla_q_norm': mla_q_norm[l], 'mla_k_norm': mla_k_norm[l],
            'mla_w_uk': mla_w_uk[l], 'mla_w_uv': mla_w_uv[l],
            'ssm_lam_re': ssm_lam_re[l], 'ssm_lam_im': ssm_lam_im[l], 'ssm_log_dt': ssm_log_dt[l],
            'ssm_b_re': ssm_b_re[l], 'ssm_b_im': ssm_b_im[l], 'ssm_c_re': ssm_c_re[l], 'ssm_c_im': ssm_c_im[l],
            'ssm_d': ssm_d[l], 'ssm_w_glu': ssm_w_glu[l],
        }
        mod_ctx = adaln(c_ctx[None, :], w_mod[l], b_mod[l])
        mod_lat = adaln(c, w_mod[l], b_mod[l])
        xp, (k, v, ckv_n, kr, hf, hb) = trunk_layer(xp, mod_ctx, p, None)
        new_k.append(k)
        new_v.append(v)
        new_ckv.append(ckv_n)
        new_kr.append(kr)
        hs = jnp.stack([hf, hb], axis=1)
        new_ssm.append(jnp.stack([jnp.real(hs), jnp.imag(hs)], axis=-1))
        ctx = {'k': cache_attn_k[:, l], 'v': cache_attn_v[:, l], 'ckv': cache_mla_ckv[:, l], 'kr': cache_mla_krope[:, l], 'ssm': state_ssm[:, l]}
        xs, _ = trunk_layer(xs, mod_lat, p, ctx)
    return (xp, xs, jnp.stack(new_k, axis=1), jnp.stack(new_v, axis=1), jnp.stack(new_ckv, axis=1), jnp.stack(new_kr, axis=1), jnp.stack(new_ssm, axis=1))
```

```cpp
#include <hip/hip_runtime.h>
#include <hip/hip_bf16.h>
#include <hip/hip_cooperative_groups.h>
#include <cstdio>
#include <cstdint>
namespace cg = cooperative_groups;

#define LAS __attribute__((address_space(3)))
typedef unsigned short bf16_t;
typedef short bf16x8 __attribute__((ext_vector_type(8)));
typedef short s16x4 __attribute__((ext_vector_type(4)));
typedef float f32x4 __attribute__((ext_vector_type(4)));
typedef float f32x2 __attribute__((ext_vector_type(2)));
typedef float f32x16 __attribute__((ext_vector_type(16)));
typedef unsigned u32x4 __attribute__((ext_vector_type(4)));
typedef unsigned u32x2 __attribute__((ext_vector_type(2)));

constexpr int DM = 2048, DFF = 8192, NTOK = 16384, NCTXR = 8192;
constexpr int INW = 3520, INWP = 3584, KVROWS = 20480;
constexpr float EPSN = 1e-6f;
constexpr int ZU = 0, ZQB = 512, ZKB = 1280, ZVB = 1536, ZQC = 1792, ZCKV = 2944, ZKR = 3456;
constexpr size_t O_K = 33554432, O_V = 37748736, O_CKV = 41943040, O_KRO = 50331648, O_SSM = 51380224;
constexpr size_t MiB = 1u << 20;
constexpr size_t WS_XB = 902144;
constexpr size_t WS_CEN = 901120;
constexpr size_t WS_MOD = 0;
constexpr size_t WS_W = 1 * MiB;
constexpr size_t WL_IN = 0, WL_OUT = 14 * MiB, WL_FF1 = 22 * MiB, WL_FF2 = 54 * MiB, WL_GLU = 86 * MiB, WL_UKV = 87 * MiB, WL_SIZE = 89 * MiB;
constexpr size_t WS_HN = WS_W + 2 * WL_SIZE;
constexpr size_t WS_Z = WS_HN + 64 * MiB;
constexpr size_t WS_QB = WS_Z + 112 * MiB;
constexpr size_t WS_KB = WS_QB + 24 * MiB;
constexpr size_t WS_VB = WS_KB + 10 * MiB;
constexpr size_t WS_QC = WS_VB + 10 * MiB;
constexpr size_t WS_CKVN = WS_QC + 36 * MiB;
constexpr size_t WS_KR = WS_CKVN + 20 * MiB;
constexpr size_t WS_KVRAW = WS_KR + 5 * MiB;
constexpr size_t WS_KC = WS_KVRAW + 60 * MiB;
constexpr size_t WS_YF = WS_KC + 45 * MiB;
constexpr size_t WS_YB = WS_YF + 32 * MiB;
constexpr size_t WS_Y = WS_YB + 32 * MiB;
constexpr size_t WS_MIX = WS_Y + 16 * MiB;
constexpr size_t WS_END = WS_MIX + 64 * MiB;
constexpr size_t WS_HFF = WS_Z;
static_assert(WS_HFF + 256 * MiB <= WS_END, "hff overlay");
static_assert(WS_END <= 768 * MiB, "workspace");

struct Args {
    const float* in[33];
    float* out;
    unsigned char* ws;
};
typedef const __attribute__((address_space(4))) Args* AP;
#define RELOAD_ARGS() asm volatile("" : "+s"(a))

__device__ __forceinline__ unsigned f2bf(float f) { unsigned u = __builtin_bit_cast(unsigned, f); return (u + 0x7fffu + ((u >> 16) & 1u)) >> 16; }
__device__ __forceinline__ unsigned pk2(float lo, float hi) { unsigned r; asm("v_cvt_pk_bf16_f32 %0, %1, %2" : "=v"(r) : "v"(lo), "v"(hi)); return r; }
__device__ __forceinline__ float bf2f(unsigned short h) { return __builtin_bit_cast(float, (unsigned)h << 16); }
__device__ __forceinline__ float dpp_f(float v, const int ctrl_sel) {
    const int x = __builtin_bit_cast(int, v); int r;
    if (ctrl_sel == 0) r = __builtin_amdgcn_mov_dpp(x, 0xB1, 0xF, 0xF, true);
    else if (ctrl_sel == 1) r = __builtin_amdgcn_mov_dpp(x, 0x4E, 0xF, 0xF, true);
    else if (ctrl_sel == 2) r = __builtin_amdgcn_mov_dpp(x, 0x141, 0xF, 0xF, true);
    else r = __builtin_amdgcn_mov_dpp(x, 0x140, 0xF, 0xF, true);
    return __builtin_bit_cast(float, r);
}
__device__ __forceinline__ float wave_sum(float v) {
    v += dpp_f(v, 0); v += dpp_f(v, 1); v += dpp_f(v, 2); v += dpp_f(v, 3);
    v += __builtin_bit_cast(float, __builtin_amdgcn_ds_swizzle(__builtin_bit_cast(int, v), 0x401F));
    { auto rr = __builtin_amdgcn_permlane32_swap(__float_as_uint(v), __float_as_uint(v), false, false); v = __uint_as_float(rr[0]) + __uint_as_float(rr[1]); }
    return v;
}

namespace pg8 {
#define PG8_LAS __attribute__((address_space(3)))
constexpr int BM = 256, BK = 64, HALF = 128, HTB = HALF * BK * 2, STAGE_BYTES = 8 * HTB, NXCD = 8, WGM = 8;

__host__ __device__ __forceinline__ int lds_byte(int r, int c) { const int st = (r >> 4) * 2 + (c >> 5), rr = r & 15, cc = c & 31, ob = rr * 64 + cc * 2; return st * 1024 + (ob ^ (((ob >> 9) & 1) << 5)); }
__host__ __device__ __forceinline__ void stage_rc(int b, int& R, int& C) { const int st = b / 1024, sb = b % 1024, swz = sb ^ (((sb >> 9) & 1) << 5); R = (st >> 1) * 16 + swz / 64; C = (st & 1) * 32 + (swz % 64) / 2; }
__host__ __device__ __forceinline__ int perm32(int rho) { const int n = rho >> 4, i = rho & 15; return 8 * (i >> 2) + 4 * n + (i & 3); }

struct Unit { int pm, pn; };
struct Gemm { const bf16_t* A; const bf16_t* Bt; int M, N, K; };

struct StaticOrder {
    int nM, nN, nwg, start, end, xn, xr;
    __host__ __device__ void init(int M, int N, int G, int xp, int xn_, int xr_) { nM = M / BM; nN = N / BM; nwg = nM * nN; xn = xn_; xr = xr_;
        start = (int)((long)nwg * xp / G); end = (int)((long)nwg * (xp + xn_) / G); }
    __host__ __device__ bool next(int i, Unit& u) const {
        const int wgid = start + i * xn + xr; if (wgid >= end) return false;
        const int nig = WGM * nN, gid = wgid / nig, fm = gid * WGM, gsz = (nM - fm) < WGM ? (nM - fm) : WGM;
        u.pm = fm + ((wgid % nig) % gsz); u.pn = (wgid % nig) / gsz; return true;
    }
    __device__ __forceinline__ void a_ready(const Unit&) const {}
    __device__ __forceinline__ void done(const Unit&) const {}
};

template <int ACT  > struct EpiBf16 {
    static constexpr bool PERM = true, AFTER_DRAIN = false;
    bf16_t* O; int ldc;
    __device__ __forceinline__ void operator()(const f32x4 (&acc)[2][2][4][2], const Unit& u, int wr, int wc, int fr, int fq) const {
        const int row0 = u.pm * BM + wr * 64 + fr; const int col0 = u.pn * BM + wc * 32 + 8 * fq;
#pragma unroll
        for (int ai = 0; ai < 2; ++ai)
#pragma unroll
            for (int m = 0; m < 4; ++m) { bf16_t* rowp = O + (size_t)(row0 + ai * HALF + m * 16) * ldc + col0;
#pragma unroll
                for (int bj = 0; bj < 2; ++bj) { f32x4 v0 = acc[ai][bj][m][0], v1 = acc[ai][bj][m][1];
                    if (ACT == 2) {
#pragma unroll
                        for (int j = 0; j < 4; ++j) { float a = fmaxf(v0[j], 0.f), b = fmaxf(v1[j], 0.f); v0[j] = a * a; v1[j] = b * b; } }
                    u32x4 w; w.x = pk2(v0[0], v0[1]); w.y = pk2(v0[2], v0[3]); w.z = pk2(v1[0], v1[1]); w.w = pk2(v1[2], v1[3]);
                    *(u32x4*)(rowp + bj * HALF) = w; } }
    }
};
struct EpiGlu {
    static constexpr bool PERM = true, AFTER_DRAIN = false;
    bf16_t* O; int ldc;
    __device__ __forceinline__ void operator()(const f32x4 (&acc)[2][2][4][2], const Unit& u, int wr, int wc, int fr, int fq) const {
        const int row0 = u.pm * BM + wr * 64 + fr; const int col0 = u.pn * HALF + wc * 32 + 8 * fq;
#pragma unroll
        for (int ai = 0; ai < 2; ++ai)
#pragma unroll
            for (int m = 0; m < 4; ++m) { bf16_t* rowp = O + (size_t)(row0 + ai * HALF + m * 16) * ldc + col0;
                float o[8];
#pragma unroll
                for (int n = 0; n < 2; ++n)
#pragma unroll
                    for (int j = 0; j < 4; ++j) { const float a = acc[ai][0][m][n][j], g = acc[ai][1][m][n][j]; o[n * 4 + j] = a / (1.f + __expf(-g)); }
                u32x4 w; w.x = pk2(o[0], o[1]); w.y = pk2(o[2], o[3]); w.z = pk2(o[4], o[5]); w.w = pk2(o[6], o[7]);
                *(u32x4*)rowp = w; }
    }
};
struct EpiResGate {
    static constexpr bool PERM = false, AFTER_DRAIN = false;
    const float* xin0; const float* xin1; float* out; const float* gate;
    __device__ __forceinline__ void operator()(const f32x4 (&acc)[2][2][4][2], const Unit& u, int wr, int wc, int fr, int fq) const {
        const int rowt = u.pm * BM; const int set = rowt < NCTXR ? 0 : 1 + ((rowt - NCTXR) >> 10);
        const float* gp = gate + (size_t)set * 12288 + u.pn * BM + wc * 32 + 4 * fq;
        const float* xb = rowt < NCTXR ? xin0 + (size_t)rowt * DM : xin1 + (size_t)(rowt - NCTXR) * DM;
        f32x4 gv[2][2];
#pragma unroll
        for (int bj = 0; bj < 2; ++bj)
#pragma unroll
            for (int n = 0; n < 2; ++n) gv[bj][n] = *(const f32x4*)(gp + bj * HALF + n * 16);
#pragma unroll
        for (int ai = 0; ai < 2; ++ai)
#pragma unroll
            for (int m = 0; m < 4; ++m) { const int rl = ai * HALF + wr * 64 + m * 16 + fr; const size_t off = (size_t)rl * DM + u.pn * BM + wc * 32 + 4 * fq;
#pragma unroll
                for (int bj = 0; bj < 2; ++bj)
#pragma unroll
                    for (int n = 0; n < 2; ++n) { const f32x4 xv = *(const f32x4*)(xb + off + bj * HALF + n * 16);
                        *(f32x4*)(out + (size_t)rowt * DM + off + bj * HALF + n * 16) = xv + gv[bj][n] * acc[ai][bj][m][n]; } }
    }
};

template <class Epi, class Sched, bool ALIGN_EPI = false, bool SP2 = false>
__device__ __forceinline__ void gemm_phase(PG8_LAS unsigned char* lds, const Gemm g, const Sched& S, const Epi& E, const int tid) {
    const int wid = __builtin_amdgcn_readfirstlane(tid >> 6), lane = tid & 63, wr = wid >> 2, wc = wid & 3, fr = lane & 15, fq = lane >> 4;
    const int K = g.K, nt = K / BK;
    unsigned voffA[2], voffB[2];
#pragma unroll
    for (int i = 0; i < 2; ++i) { int R, C; stage_rc(tid * 16 + i * 8192, R, C); const int Rb = Epi::PERM ? ((R & ~31) + perm32(R & 31)) : R;
        voffA[i] = (unsigned)(R * K + C) * 2u; voffB[i] = (unsigned)(Rb * K + C) * 2u; }
    const size_t kstep = (size_t)(BK * 2);
    const size_t hstep = (size_t)HALF * K * 2;
    const size_t tstep = 2 * hstep;
    const unsigned ldsw = (unsigned)wid * 1024u;
    const int aoff = lds_byte(wr * 64 + fr, fq * 8), boff = lds_byte(wc * 32 + fr, fq * 8);
#define PG8_SA(b, h) (((b) * 2 + (h)) * HTB)
#define PG8_SB(b, h) ((4 + (b) * 2 + (h)) * HTB)
#define PG8_STAGE(bufoff, gbase, voff) do { _Pragma("unroll") for (int _i = 0; _i < 2; ++_i) \
        __builtin_amdgcn_global_load_lds((const unsigned*)((const char*)(gbase) + (voff)[_i]), (PG8_LAS unsigned*)(lds + (bufoff) + ldsw + _i * 8192), 16, 0, 0); } while (0)
#define PG8_LDA(dst, b, h) do { _Pragma("unroll") for (int m = 0; m < 4; ++m) _Pragma("unroll") for (int k = 0; k < 2; ++k) dst[m][k] = *(const PG8_LAS bf16x8*)(lds + PG8_SA(b, h) + aoff + m * 2048 + k * 1024); } while (0)
#define PG8_LDB(dst, b, h) do { _Pragma("unroll") for (int n = 0; n < 2; ++n) _Pragma("unroll") for (int k = 0; k < 2; ++k) dst[n][k] = *(const PG8_LAS bf16x8*)(lds + PG8_SB(b, h) + boff + n * 2048 + k * 1024); } while (0)
#define PG8_MMA(ai, bj, At, Bt) do { __builtin_amdgcn_s_setprio(1); _Pragma("unroll") for (int m = 0; m < 4; ++m) _Pragma("unroll") for (int n = 0; n < 2; ++n) _Pragma("unroll") for (int k = 0; k < 2; ++k) \
        acc[ai][bj][m][n] = __builtin_amdgcn_mfma_f32_16x16x32_bf16(Bt[n][k], At[m][k], acc[ai][bj][m][n], 0, 0, 0); __builtin_amdgcn_s_setprio(0); } while (0)
#define PG8_WAIT_V(n) asm volatile("s_waitcnt vmcnt(" #n ")" ::: "memory")
#define PG8_WAIT_L(n) asm volatile("s_waitcnt lgkmcnt(" #n ")" ::: "memory")
#define PG8_BAR __builtin_amdgcn_s_barrier()
#define PG8_SCHED __builtin_amdgcn_sched_barrier(0)
    Unit cur, nxt; int ui = 0;
    if (!S.next(0, cur)) return;
    f32x4 acc[2][2][4][2];
#pragma unroll
    for (int a = 0; a < 2; ++a)
#pragma unroll
        for (int b = 0; b < 2; ++b)
#pragma unroll
            for (int m = 0; m < 4; ++m)
#pragma unroll
                for (int n = 0; n < 2; ++n) acc[a][b][m][n] = (f32x4){0.f, 0.f, 0.f, 0.f};
    bf16x8 At[4][2], B0[2][2], B1[2][2];
    const char* cA = (const char*)g.A + (size_t)cur.pm * tstep; const char* cB = (const char*)g.Bt + (size_t)cur.pn * tstep;
    S.a_ready(cur);
    if constexpr (SP2) {
        PG8_STAGE(PG8_SB(0, 0), cB, voffB); PG8_STAGE(PG8_SB(0, 1), cB + hstep, voffB); PG8_STAGE(PG8_SA(0, 0), cA, voffA); PG8_STAGE(PG8_SA(0, 1), cA + hstep, voffA);
        if (wr == 1) PG8_BAR;
        PG8_WAIT_V(2); PG8_BAR;
        PG8_STAGE(PG8_SB(1, 0), cB + kstep, voffB); PG8_STAGE(PG8_SA(1, 0), cA + kstep, voffA); PG8_STAGE(PG8_SB(1, 1), cB + hstep + kstep, voffB);
        PG8_WAIT_V(6); PG8_BAR;
    } else {
        PG8_STAGE(PG8_SB(0, 0), cB, voffB); PG8_STAGE(PG8_SA(0, 0), cA, voffA); PG8_STAGE(PG8_SB(0, 1), cB + hstep, voffB); PG8_STAGE(PG8_SA(0, 1), cA + hstep, voffA);
        if (wr == 1) PG8_BAR;
        PG8_WAIT_V(4); PG8_BAR;
        PG8_STAGE(PG8_SB(1, 0), cB + kstep, voffB); PG8_STAGE(PG8_SA(1, 0), cA + kstep, voffA); PG8_STAGE(PG8_SB(1, 1), cB + hstep + kstep, voffB);
        PG8_WAIT_V(6); PG8_BAR;
    }
    for (;;) {
        const bool has_next = S.next(ui + 1, nxt);
        const char* nA = has_next ? (const char*)g.A + (size_t)nxt.pm * tstep : cA; const char* nB = has_next ? (const char*)g.Bt + (size_t)nxt.pn * tstep : cB;
        for (int t = 0; t < nt; t += 2) {
            const bool last = (t == nt - 2);
            const char* a1 = cA + (size_t)(t + 1) * kstep;
            const char* a2 = last ? nA : cA + (size_t)(t + 2) * kstep; const char* b2 = last ? nB : cB + (size_t)(t + 2) * kstep;
            const char* a3 = a2 + kstep; const char* b3 = b2 + kstep;
            if (last && has_next) S.a_ready(nxt);
            if constexpr (SP2) {
            PG8_LDB(B0, 0, 0); PG8_LDB(B1, 0, 1); PG8_SCHED; PG8_LDA(At, 0, 0); PG8_STAGE(PG8_SA(1, 1), a1 + hstep, voffA);
            PG8_WAIT_V(8); PG8_WAIT_L(0); PG8_BAR; PG8_MMA(0, 0, At, B0); PG8_MMA(0, 1, At, B1); PG8_BAR; PG8_SCHED;
            PG8_LDA(At, 0, 1); PG8_STAGE(PG8_SB(0, 0), b2, voffB); PG8_STAGE(PG8_SB(0, 1), b2 + hstep, voffB); PG8_STAGE(PG8_SA(0, 0), a2, voffA);
            PG8_WAIT_V(8); PG8_WAIT_L(0); PG8_BAR; PG8_MMA(1, 0, At, B0); PG8_MMA(1, 1, At, B1); PG8_BAR; PG8_SCHED;
            PG8_LDB(B0, 1, 0); PG8_LDB(B1, 1, 1); PG8_SCHED; PG8_LDA(At, 1, 0); PG8_STAGE(PG8_SA(0, 1), a2 + hstep, voffA);
            PG8_WAIT_V(8); PG8_WAIT_L(0); PG8_BAR; PG8_MMA(0, 0, At, B0); PG8_MMA(0, 1, At, B1); PG8_BAR; PG8_SCHED;
            PG8_LDA(At, 1, 1); PG8_STAGE(PG8_SB(1, 0), b3, voffB); PG8_STAGE(PG8_SB(1, 1), b3 + hstep, voffB); PG8_STAGE(PG8_SA(1, 0), a3, voffA);
            PG8_WAIT_V(8); PG8_WAIT_L(0); PG8_BAR; PG8_MMA(1, 0, At, B0); PG8_MMA(1, 1, At, B1); PG8_BAR; PG8_SCHED;
            } else {
            PG8_LDB(B0, 0, 0); PG8_SCHED; PG8_LDA(At, 0, 0); PG8_STAGE(PG8_SA(1, 1), a1 + hstep, voffA);
            PG8_WAIT_L(8); PG8_BAR; PG8_WAIT_L(0); PG8_MMA(0, 0, At, B0); PG8_BAR; PG8_SCHED;
            PG8_LDB(B1, 0, 1); PG8_STAGE(PG8_SB(0, 0), b2, voffB);
            PG8_BAR; PG8_WAIT_L(0); PG8_MMA(0, 1, At, B1); PG8_BAR;
            PG8_LDA(At, 0, 1); PG8_STAGE(PG8_SA(0, 0), a2, voffA);
            PG8_BAR; PG8_WAIT_L(0); PG8_MMA(1, 0, At, B0); PG8_BAR; PG8_SCHED;
            PG8_STAGE(PG8_SB(0, 1), b2 + hstep, voffB);
            PG8_WAIT_V(6); PG8_BAR; PG8_MMA(1, 1, At, B1); PG8_BAR;
            PG8_LDB(B0, 1, 0); PG8_SCHED; PG8_LDA(At, 1, 0); PG8_STAGE(PG8_SA(0, 1), a2 + hstep, voffA);
            PG8_WAIT_L(8); PG8_BAR; PG8_WAIT_L(0); PG8_MMA(0, 0, At, B0); PG8_BAR; PG8_SCHED;
            PG8_LDB(B1, 1, 1); PG8_STAGE(PG8_SB(1, 0), b3, voffB);
            PG8_BAR; PG8_WAIT_L(0); PG8_MMA(0, 1, At, B1); PG8_BAR;
            PG8_LDA(At, 1, 1); PG8_STAGE(PG8_SA(1, 0), a3, voffA);
            PG8_BAR; PG8_WAIT_L(0); PG8_MMA(1, 0, At, B0); PG8_BAR; PG8_SCHED;
            PG8_STAGE(PG8_SB(1, 1), b3 + hstep, voffB);
            PG8_WAIT_V(6); PG8_BAR; PG8_MMA(1, 1, At, B1); PG8_BAR;
            }
        }
        if constexpr (ALIGN_EPI) { if (wr == 0) PG8_BAR; }
        if constexpr (!Epi::AFTER_DRAIN) { E(acc, cur, wr, wc, fr, fq); S.done(cur); }
        if (!has_next) break;
#pragma unroll
        for (int a = 0; a < 2; ++a)
#pragma unroll
            for (int b = 0; b < 2; ++b)
#pragma unroll
                for (int m = 0; m < 4; ++m)
#pragma unroll
                    for (int n = 0; n < 2; ++n) acc[a][b][m][n] = (f32x4){0.f, 0.f, 0.f, 0.f};
        cur = nxt; cA = nA; cB = nB; ++ui;
        if constexpr (ALIGN_EPI) { if (wr == 1) PG8_BAR; }
    }
    PG8_WAIT_V(0);
    if constexpr (!ALIGN_EPI) { if (wr == 0) PG8_BAR; }
    PG8_BAR;
#undef PG8_SA
#undef PG8_SB
#undef PG8_STAGE
#undef PG8_LDA
#undef PG8_LDB
#undef PG8_MMA
#undef PG8_WAIT_V
#undef PG8_WAIT_L
#undef PG8_BAR
#undef PG8_SCHED
}
}

namespace att {
constexpr int NW = 8, QBLK = 32, KVBLK = 64, LDO = 2048;
constexpr size_t SHM_V = KVBLK * 128 * 2, SHM_K = KVBLK * 128 * 2, SHM_KR = KVBLK * 64 * 2;
constexpr size_t OFF_K = 2 * SHM_V, OFF_KR = OFF_K + 2 * SHM_K, OFF_WS = OFF_KR + 2 * SHM_KR, OFF_QR = OFF_WS + NW * 64 * 4, SHM_ATTN = OFF_QR + NW * 4 * 64 * 16;
#define KSWZ(row, colB) ((row) * 256 + ((colB) ^ (((row) & 7) << 4)))
#define KRSWZ(row, colB) ((row) * 128 + ((colB) ^ (((row) & 7) << 4)))
#define SBAR() __builtin_amdgcn_sched_barrier(0)
__device__ __forceinline__ int crow(int r, int hi) { return (r & 3) + 8 * (r >> 2) + 4 * hi; }
__device__ __forceinline__ unsigned cvtpk(float lo, float hi) { unsigned r; asm volatile("v_cvt_pk_bf16_f32 %0, %1, %2" : "=v"(r) : "v"(lo), "v"(hi)); return r; }
constexpr float THR = 8.f;

template <int DQK> struct Sc { static constexpr float SCALE = DQK == 128 ? 0.088388347648318440f : 0.072168783648703220f; };

template <int DQK> __device__ __forceinline__ void partialSM(f32x16& p0, f32x16& p1, float& m_reg, float& mn, float& alpha) {
  constexpr float SCALE = Sc<DQK>::SCALE; constexpr float C = SCALE * 1.4426950408889634f;
  float pmax = p0[0];
#pragma unroll
  for (int r = 1; r < 16; ++r) pmax = fmaxf(pmax, p0[r]);
#pragma unroll
  for (int r = 0; r < 16; ++r) pmax = fmaxf(pmax, p1[r]);
  { auto rr = __builtin_amdgcn_permlane32_swap(__float_as_uint(pmax), __float_as_uint(pmax), false, false);
    pmax = fmaxf(__uint_as_float(rr[0]), __uint_as_float(rr[1])); }
  if (__builtin_expect(__all(pmax - m_reg <= THR / SCALE), 1)) { mn = m_reg; alpha = 1.f; }
  else { mn = fmaxf(m_reg, pmax); alpha = __builtin_amdgcn_exp2f((m_reg - mn) * C); m_reg = mn; }
  float mnC = -mn * C;
#pragma unroll
  for (int r = 0; r < 16; ++r) p0[r] = fmaf(p0[r], C, mnC);
#pragma unroll
  for (int r = 0; r < 16; ++r) p1[r] = fmaf(p1[r], C, mnC);
#pragma unroll
  for (int r = 0; r < 16; ++r) p0[r] = __builtin_amdgcn_exp2f(p0[r]);
}
__device__ __forceinline__ void finishSM(f32x16& p0, f32x16& p1, float alpha, float& l_reg, bf16x8& pa0, bf16x8& pa1, bf16x8& pa2, bf16x8& pa3) {
#pragma unroll
  for (int r = 0; r < 16; ++r) p1[r] = __builtin_amdgcn_exp2f(p1[r]);
  float ps = 0;
#pragma unroll
  for (int r = 0; r < 16; ++r) ps += p0[r];
#pragma unroll
  for (int r = 0; r < 16; ++r) ps += p1[r];
  { auto rr = __builtin_amdgcn_permlane32_swap(__float_as_uint(ps), __float_as_uint(ps), false, false);
    ps = __uint_as_float(rr[0]) + __uint_as_float(rr[1]); }
  l_reg = l_reg * alpha + ps;
#define PK4(P, BASE, OUT) do { unsigned a0 = cvtpk(P[BASE + 0], P[BASE + 1]), a1 = cvtpk(P[BASE + 2], P[BASE + 3]);   \
    unsigned b0 = cvtpk(P[BASE + 4], P[BASE + 5]), b1 = cvtpk(P[BASE + 6], P[BASE + 7]);                              \
    auto r0 = __builtin_amdgcn_permlane32_swap(a0, b0, false, false); auto r1 = __builtin_amdgcn_permlane32_swap(a1, b1, false, false); \
    u32x4 w = {r0[0], r1[0], r0[1], r1[1]}; OUT = *reinterpret_cast<bf16x8*>(&w); } while (0)
  PK4(p0, 0, pa0); PK4(p0, 8, pa1); PK4(p1, 0, pa2); PK4(p1, 8, pa3);
#undef PK4
}
template <int DQK> __device__ __forceinline__ void qkt(f32x16& p0, f32x16& p1, const char* Ks, const char* Krs, const bf16x8* qr, const char* qrl, int r32, int hi) {
  p0 = f32x16{}; p1 = f32x16{};
#pragma unroll
  for (int d0 = 0; d0 < 8; ++d0) { int cb = (d0 * 16 + hi * 8) * 2;
    bf16x8 b0 = *reinterpret_cast<const bf16x8*>(Ks + KSWZ(r32, cb));
    bf16x8 b1 = *reinterpret_cast<const bf16x8*>(Ks + KSWZ(32 + r32, cb));
    p0 = __builtin_amdgcn_mfma_f32_32x32x16_bf16(b0, qr[d0], p0, 0, 0, 0);
    p1 = __builtin_amdgcn_mfma_f32_32x32x16_bf16(b1, qr[d0], p1, 0, 0, 0); }
  if constexpr (DQK == 192) {
#pragma unroll
    for (int d0 = 0; d0 < 4; ++d0) { int cb = (d0 * 16 + hi * 8) * 2;
      bf16x8 b0 = *reinterpret_cast<const bf16x8*>(Krs + KRSWZ(r32, cb));
      bf16x8 b1 = *reinterpret_cast<const bf16x8*>(Krs + KRSWZ(32 + r32, cb));
      const bf16x8 qf = *reinterpret_cast<const bf16x8*>(qrl + d0 * 1024);
      p0 = __builtin_amdgcn_mfma_f32_32x32x16_bf16(b0, qf, p0, 0, 0, 0);
      p1 = __builtin_amdgcn_mfma_f32_32x32x16_bf16(b1, qf, p1, 0, 0, 0); }
  }
}
__device__ __forceinline__ int v_st(int k, int c) { const int kk = (k & ~0xC) | ((k & 4) << 1) | ((k & 8) >> 1); return ((kk >> 3) * 4 + (c >> 5)) * 512 + ((kk & 7) * 32 + (c & 31)) * 2; }
__device__ __forceinline__ int v_rd_base(int lane) { return ((lane & 3) << 3) | (((lane >> 2) & 3) << 6) | (((lane >> 4) & 1) << 5) | (((lane >> 5) & 1) << 8); }
constexpr int v_rd_off(int d0, int ks, int half) { return d0 * 512 + ks * 4096 + half * 2048; }
template <int OFF> __device__ __forceinline__ s16x4 tr_read(int vb) {
  s16x4 r; asm volatile("ds_read_b64_tr_b16 %0, %1 offset:%2" : "=&v"(r) : "v"(vb), "i"(OFF) : "memory"); return r;
}
template <int D0> __device__ __forceinline__ void pv_one(f32x16& od, int vb, bf16x8 pa0, bf16x8 pa1, bf16x8 pa2, bf16x8 pa3) {
  const s16x4 l0 = tr_read<v_rd_off(D0, 0, 0)>(vb), h0 = tr_read<v_rd_off(D0, 0, 1)>(vb), l1 = tr_read<v_rd_off(D0, 1, 0)>(vb), h1 = tr_read<v_rd_off(D0, 1, 1)>(vb);
  const s16x4 l2 = tr_read<v_rd_off(D0, 2, 0)>(vb), h2 = tr_read<v_rd_off(D0, 2, 1)>(vb), l3 = tr_read<v_rd_off(D0, 3, 0)>(vb), h3 = tr_read<v_rd_off(D0, 3, 1)>(vb);
  asm volatile("s_waitcnt lgkmcnt(0)" ::: "memory"); SBAR();
#define PK(L, H) (bf16x8){L[0], L[1], L[2], L[3], H[0], H[1], H[2], H[3]}
  od = __builtin_amdgcn_mfma_f32_32x32x16_bf16(pa0, PK(l0, h0), od, 0, 0, 0);
  od = __builtin_amdgcn_mfma_f32_32x32x16_bf16(pa1, PK(l1, h1), od, 0, 0, 0);
  od = __builtin_amdgcn_mfma_f32_32x32x16_bf16(pa2, PK(l2, h2), od, 0, 0, 0);
  od = __builtin_amdgcn_mfma_f32_32x32x16_bf16(pa3, PK(l3, h3), od, 0, 0, 0);
#undef PK
}
__device__ __forceinline__ void pv_d0(f32x16* o, int vb, bf16x8 pa0, bf16x8 pa1, bf16x8 pa2, bf16x8 pa3) {
  pv_one<0>(o[0], vb, pa0, pa1, pa2, pa3); pv_one<1>(o[1], vb, pa0, pa1, pa2, pa3); pv_one<2>(o[2], vb, pa0, pa1, pa2, pa3); pv_one<3>(o[3], vb, pa0, pa1, pa2, pa3);
}

template <int DQK, int LDQ, int LDK, int LDV>
__device__ __forceinline__ void attn_body(const bf16_t* __restrict__ Qb, const bf16_t* __restrict__ Kh, const bf16_t* __restrict__ Vh,
                                          bf16_t* __restrict__ Ob, int seq, char* lds, const int tid) {
  constexpr int NQ = 8; constexpr int SD = DQK == 192 ? 1 : 2;
  const int wid = tid >> 6, lane = tid & 63, r32 = lane & 31, hi = lane >> 5;
  char* V_lds = lds; char* K_lds = lds + OFF_K; char* KR_lds = lds + OFF_KR;
  float* ws = (float*)(lds + OFF_WS) + wid * 64; float* li_l = ws; float* al_l = ws + 32;
  float m_reg = -1e30f, l_reg = 0; f32x16 o[4] = {}; bf16x8 qr[NQ];
  const bf16_t* Qw = Qb + (long)(wid * QBLK + r32) * LDQ + hi * 8;
#pragma unroll
  for (int d0 = 0; d0 < NQ; ++d0) qr[d0] = *reinterpret_cast<const bf16x8*>(Qw + d0 * 16);
  char* qrl = lds + OFF_QR + wid * 4096 + lane * 16;
  if constexpr (DQK == 192) {
#pragma unroll
    for (int d0 = 0; d0 < 4; ++d0) *reinterpret_cast<bf16x8*>(qrl + d0 * 1024) = *reinterpret_cast<const bf16x8*>(Qw + 128 + d0 * 16);
  }
  const int sr = tid >> 4, sc = (tid & 15) * 8, vst0 = v_st(sr, sc), vst1 = v_st(32 + sr, sc);
  const int rr_ = tid >> 3, rc_ = (tid & 7) * 8;
  const int vb0 = (int)(uintptr_t)V_lds + v_rd_base(lane);
  struct { bf16x8 vs0, vs1, ks0, ks1, kr; } sr_[SD];
  const unsigned voffV = (unsigned)(sr * LDV + sc) * 2u, voffK = (unsigned)(sr * LDK + sc) * 2u, voffR = (unsigned)(rr_ * LDK + 128 + rc_) * 2u;
#define SLOAD(i, k0) do { const char* vb_ = (const char*)(Vh + (size_t)(k0) * LDV); const char* kb_ = (const char*)(Kh + (size_t)(k0) * LDK); \
    sr_[i].vs0 = *(const bf16x8*)(vb_ + voffV); sr_[i].vs1 = *(const bf16x8*)(vb_ + 32 * LDV * 2 + voffV); \
    sr_[i].ks0 = *(const bf16x8*)(kb_ + voffK); sr_[i].ks1 = *(const bf16x8*)(kb_ + 32 * LDK * 2 + voffK); \
    if constexpr (DQK == 192) sr_[i].kr = *(const bf16x8*)(kb_ + voffR); } while (0)
#define SWRITE(b, i) do { *(bf16x8*)(V_lds + (b) * SHM_V + vst0) = sr_[i].vs0;          \
    *(bf16x8*)(V_lds + (b) * SHM_V + vst1) = sr_[i].vs1; int kc = sc * 2;               \
    *(bf16x8*)(K_lds + (b) * SHM_K + KSWZ(sr, kc)) = sr_[i].ks0;                       \
    *(bf16x8*)(K_lds + (b) * SHM_K + KSWZ(32 + sr, kc)) = sr_[i].ks1;                  \
    if constexpr (DQK == 192) *(bf16x8*)(KR_lds + (b) * SHM_KR + KRSWZ(rr_, rc_ * 2)) = sr_[i].kr; } while (0)
#define SWAIT() do { if constexpr (SD == 1) asm volatile("s_waitcnt vmcnt(0)" ::: "memory"); else asm volatile("s_waitcnt vmcnt(4)" ::: "memory"); } while (0)
#define RESC(a) do { if (__any((a) < 1.f)) { if (hi == 0) al_l[r32] = (a); asm volatile("s_waitcnt lgkmcnt(0)" ::: "memory"); \
    _Pragma("unroll") for (int d = 0; d < 4; ++d) _Pragma("unroll") for (int r = 0; r < 16; ++r) o[d][r] *= al_l[crow(r, hi)]; } } while (0)
  f32x16 pA0, pA1, pB0, pB1; float mnA, mnB, alA, alB; bf16x8 pa0, pa1, pa2, pa3; const int NT = seq / KVBLK;
  constexpr int SE = 0, SO = SD - 1;
  SLOAD(SE, 0); asm volatile("s_waitcnt vmcnt(0)" ::: "memory"); SWRITE(0, SE); __syncthreads();
  qkt<DQK>(pA0, pA1, K_lds, KR_lds, qr, qrl, r32, hi); partialSM<DQK>(pA0, pA1, m_reg, mnA, alA);
  SLOAD(SO, KVBLK); if constexpr (SD == 2) { if (2 < NT) SLOAD(SE, 2 * KVBLK); }
  SWAIT(); SWRITE(1, SO); __syncthreads();
  for (int j = 1; j + 1 < NT; j += 2) {
    SBAR(); qkt<DQK>(pB0, pB1, K_lds + SHM_K, KR_lds + SHM_KR, qr, qrl, r32, hi);
    finishSM(pA0, pA1, alA, l_reg, pa0, pa1, pa2, pa3); SBAR();
    SLOAD(SO, (j + SD) * KVBLK); SBAR();
    pv_d0(o, vb0, pa0, pa1, pa2, pa3); partialSM<DQK>(pB0, pB1, m_reg, mnB, alB);
    __syncthreads(); SWAIT(); SWRITE(0, SE);
    RESC(alB); __syncthreads();
    SBAR(); qkt<DQK>(pA0, pA1, K_lds, KR_lds, qr, qrl, r32, hi);
    finishSM(pB0, pB1, alB, l_reg, pa0, pa1, pa2, pa3); SBAR();
    if (SD == 1 || j + 3 < NT) SLOAD(SE, (j + 1 + SD) * KVBLK); SBAR();
    pv_d0(o, vb0 + (int)SHM_V, pa0, pa1, pa2, pa3); partialSM<DQK>(pA0, pA1, m_reg, mnA, alA);
    __syncthreads(); SWAIT(); SWRITE(1, SO);
    RESC(alA); __syncthreads();
  }
  SBAR(); qkt<DQK>(pB0, pB1, K_lds + SHM_K, KR_lds + SHM_KR, qr, qrl, r32, hi);
  finishSM(pA0, pA1, alA, l_reg, pa0, pa1, pa2, pa3); SBAR();
  pv_d0(o, vb0, pa0, pa1, pa2, pa3); partialSM<DQK>(pB0, pB1, m_reg, mnB, alB);
  __syncthreads(); RESC(alB);
  finishSM(pB0, pB1, alB, l_reg, pa0, pa1, pa2, pa3); SBAR();
  pv_d0(o, vb0 + (int)SHM_V, pa0, pa1, pa2, pa3);
  LAS unsigned char* ldsl = (LAS unsigned char*)lds;
  LAS float* li3 = (LAS float*)(ldsl + OFF_WS) + wid * 64;
  if (hi == 0) li3[r32] = l_reg; asm volatile("s_waitcnt lgkmcnt(0)" ::: "memory");
  float rli[16];
#pragma unroll
  for (int r = 0; r < 16; ++r) rli[r] = __builtin_amdgcn_rcpf(li3[crow(r, hi)]);
  __syncthreads();
  { LAS bf16_t* stg = (LAS bf16_t*)(ldsl + wid * 8192);
#pragma unroll
    for (int r = 0; r < 16; ++r) { const int orow = crow(r, hi);
#pragma unroll
      for (int d0 = 0; d0 < 4; ++d0) stg[orow * 128 + d0 * 32 + r32] = (bf16_t)f2bf(o[d0][r] * rli[r]); }
    asm volatile("s_waitcnt lgkmcnt(0)" ::: "memory");
    bf16_t* Obl = Ob; asm volatile("" : "+s"(Obl));
    int lane_l = lane; asm volatile("" : "+v"(lane_l));
    bf16_t* Ow = Obl + (long)(wid * QBLK + (lane_l >> 4)) * LDO + (lane_l & 15) * 8;
    const LAS bf16_t* sp = stg + (lane_l >> 4) * 128 + (lane_l & 15) * 8;
#pragma unroll 1
    for (int i = 0; i < 8; ++i) { const u32x4 v = *(const LAS u32x4*)(sp + i * 512); *(u32x4*)Ow = v; Ow += 4 * LDO; } }
  __syncthreads();
#undef SLOAD
#undef SWRITE
#undef SWAIT
#undef RESC
}
}

constexpr int NWAVES = 8, NTHR = 512;
constexpr int LDS_BYTES = 131072 + 1024;

struct Ctx {
    int tid, lane, wave, G, gw, NGW, bx;
    int xp, xn, xr, vc;
};

__device__ __forceinline__ void p0_transpose_item(const float* W, int K, int N, bf16_t* WT, int k0, int n0, int drow0, LAS float* scr, int lane) {
#pragma unroll 8
    for (int i = 0; i < 32; ++i) { const int kk = 2 * i + (lane >> 5); scr[kk * 33 + (lane & 31)] = W[(size_t)(k0 + kk) * N + n0 + (lane & 31)]; }
    asm volatile("s_waitcnt lgkmcnt(0)" ::: "memory");
    const int c = lane & 7;
#pragma unroll
    for (int j = 0; j < 4; ++j) { const int n = (lane >> 3) + 8 * j; const LAS float* s = scr + (8 * c) * 33 + n;
        u32x4 o; o.x = pk2(s[0 * 33], s[1 * 33]); o.y = pk2(s[2 * 33], s[3 * 33]); o.z = pk2(s[4 * 33], s[5 * 33]); o.w = pk2(s[6 * 33], s[7 * 33]);
        *(u32x4*)(WT + (size_t)(drow0 + n) * K + k0 + 8 * c) = o; }
    asm volatile("s_waitcnt lgkmcnt(0)" ::: "memory");
}

__device__ __forceinline__ void phase0(AP a, const Ctx& c, LAS unsigned char* lds) {
    LAS float* sil = (LAS float*)lds;
    for (int i = c.tid; i < 9 * 2048; i += NTHR) { const int s = i >> 11, k = i & 2047; const float v = s == 0 ? a->in[8][k] : a->in[7][(s - 1) * 2048 + k]; sil[i] = v / (1.f + __expf(-v)); }
    __syncthreads();
    float* mod = (float*)(a->ws + WS_MOD);
    LAS float* red = (LAS float*)(lds + 73728);
    for (int it = c.bx; it < 2 * 96; it += c.G) {
        const int l = it / 96, cb = it % 96; const int col = cb * 128 + c.lane * 2;
        const float* wp = a->in[9] + ((size_t)l * 2048 + c.wave * 256) * 12288 + col;
        f32x2 acc[9];
#pragma unroll
        for (int s = 0; s < 9; ++s) acc[s] = (f32x2){0.f, 0.f};
#pragma unroll 8
        for (int k = 0; k < 256; ++k) { const f32x2 w = *(const f32x2*)(wp + (size_t)k * 12288);
#pragma unroll
            for (int s = 0; s < 9; ++s) acc[s] += w * sil[s * 2048 + c.wave * 256 + k]; }
#pragma unroll
        for (int s = 0; s < 9; ++s) *(LAS f32x2*)(red + (c.wave * 9 + s) * 128 + c.lane * 2) = acc[s];
        __syncthreads();
        for (int idx = c.tid; idx < 9 * 128; idx += NTHR) { const int s = idx >> 7, cc = idx & 127; float v = a->in[10][(size_t)l * 12288 + cb * 128 + cc];
#pragma unroll
            for (int w = 0; w < 8; ++w) v += red[(w * 9 + s) * 128 + cc];
            mod[((size_t)l * 9 + s) * 12288 + cb * 128 + cc] = v; }
        __syncthreads();
    }
    __syncthreads();
    LAS float* scr = (LAS float*)(lds + c.wave * 8448);
    constexpr int I_IN = 32 * 110, I_OUT = 32 * 64, I_F1 = 32 * 256, I_F2 = 128 * 64, I_GLU = 8 * 32, I_UK = 8 * 24;
    constexpr int I_L = I_IN + I_OUT + I_F1 + I_F2 + I_GLU + 2 * I_UK;
    for (int it = c.gw; it < 2 * I_L; it += c.NGW) {
        const int l = it / I_L; int r = it % I_L;
        unsigned char* wl = a->ws + WS_W + (size_t)l * WL_SIZE;
        const float* W; int K, N; bf16_t* WT; int mode = 0, roff = 0;
        if (r < I_IN) { W = a->in[13] + (size_t)l * 2048 * INW; K = 2048; N = INW; WT = (bf16_t*)(wl + WL_IN); }
        else if ((r -= I_IN) < I_OUT) { W = a->in[30] + (size_t)l * 2048 * 2048; K = 2048; N = 2048; WT = (bf16_t*)(wl + WL_OUT); }
        else if ((r -= I_OUT) < I_F1) { W = a->in[31] + (size_t)l * 2048 * 8192; K = 2048; N = 8192; WT = (bf16_t*)(wl + WL_FF1); }
        else if ((r -= I_F1) < I_F2) { W = a->in[32] + (size_t)l * 8192 * 2048; K = 8192; N = 2048; WT = (bf16_t*)(wl + WL_FF2); }
        else if ((r -= I_F2) < I_GLU) { W = a->in[29] + (size_t)l * 512 * 1024; K = 512; N = 1024; WT = (bf16_t*)(wl + WL_GLU); mode = 1; }
        else if ((r -= I_GLU) < I_UK) { W = a->in[19] + (size_t)l * 512 * 768; K = 512; N = 768; WT = (bf16_t*)(wl + WL_UKV); }
        else { r -= I_UK; W = a->in[20] + (size_t)l * 512 * 768; K = 512; N = 768; WT = (bf16_t*)(wl + WL_UKV); roff = 768; }
        const int nblk = N / 32, kb = r / nblk, nb = r % nblk, k0 = 64 * kb, n0 = 32 * nb;
        int drow0 = n0 + roff;
        if (mode == 1) { drow0 = n0 < 512 ? 256 * (n0 >> 7) + (n0 & 127) : 256 * ((n0 - 512) >> 7) + 128 + ((n0 - 512) & 127); }
        p0_transpose_item(W, K, N, WT, k0, n0, drow0, scr, c.lane);
    }
    for (int i = c.gw * 64 + c.lane; i < 2 * 64 * 256; i += c.NGW * 64) { const int l = i / (64 * 256), q = i % (64 * 256);
        bf16_t* WT = (bf16_t*)(a->ws + WS_W + (size_t)l * WL_SIZE + WL_IN) + (size_t)INW * 2048;
        *(u32x4*)(WT + (size_t)q * 8) = (u32x4){0u, 0u, 0u, 0u}; }
}

__device__ __forceinline__ void phase_norm(AP a, const Ctx& c, int l, int which  , bool x_from_in) {
    const float* gw = a->in[which ? 12 : 11] + (size_t)l * DM;
    const float* modl = (const float*)(a->ws + WS_MOD) + (size_t)l * 9 * 12288;
    bf16_t* HN = (bf16_t*)(a->ws + WS_HN);
    auto xptr = [&](int r) { return x_from_in ? (r < NCTXR ? a->in[0] + (size_t)r * DM : a->in[1] + (size_t)(r - NCTXR) * DM) : a->out + (size_t)r * DM; };
    f32x4 vn[8];
    if (c.gw < NTOK) { const f32x4* xr = (const f32x4*)xptr(c.gw) + c.lane;
#pragma unroll
        for (int j = 0; j < 8; ++j) vn[j] = xr[64 * j]; }
    for (int r = c.gw; r < NTOK; r += c.NGW) {
        const int set = r < NCTXR ? 0 : 1 + ((r - NCTXR) >> 10);
        const float* shp = modl + (size_t)set * 12288 + (which ? 3 * DM : 0); const float* scp = shp + DM;
        f32x4 v[8]; float s = 0.f;
#pragma unroll
        for (int j = 0; j < 8; ++j) { v[j] = vn[j]; s += (v[j].x * v[j].x + v[j].y * v[j].y) + (v[j].z * v[j].z + v[j].w * v[j].w); }
        f32x4 gg[8], sc[8], sh[8];
#pragma unroll
        for (int j = 0; j < 8; ++j) { gg[j] = ((const f32x4*)gw)[c.lane + 64 * j]; sc[j] = ((const f32x4*)scp)[c.lane + 64 * j]; sh[j] = ((const f32x4*)shp)[c.lane + 64 * j]; }
        if (r + c.NGW < NTOK) { const f32x4* xr = (const f32x4*)xptr(r + c.NGW) + c.lane;
#pragma unroll
            for (int j = 0; j < 8; ++j) vn[j] = xr[64 * j]; }
        asm volatile("" ::: "memory");
        const float rstd = rsqrtf(wave_sum(s) * (1.f / DM) + EPSN);
        u32x2* o8 = (u32x2*)(HN + (size_t)r * DM) + c.lane;
#pragma unroll
        for (int j = 0; j < 8; ++j) { const f32x4 y = v[j] * rstd * gg[j] * (sc[j] + 1.f) + sh[j]; u32x2 w; w.x = pk2(y.x, y.y); w.y = pk2(y.z, y.w); o8[64 * j] = w; }
    }
}

constexpr float L2_10000 = 13.287712379549449f;
__device__ __forceinline__ float swz16(float v) { return __builtin_bit_cast(float, __builtin_amdgcn_ds_swizzle(__builtin_bit_cast(int, v), 0x401F)); }
__device__ __forceinline__ float swz8(float v) { return __builtin_bit_cast(float, __builtin_amdgcn_ds_swizzle(__builtin_bit_cast(int, v), 0x201F)); }
__device__ __forceinline__ float lo_bf(unsigned w) { return __builtin_bit_cast(float, w << 16); }
__device__ __forceinline__ float hi_bf(unsigned w) { return __builtin_bit_cast(float, w & 0xffff0000u); }
__device__ __forceinline__ void zpost_rows(AP a, const Ctx& c, int l) {
    const bf16_t* Z = (const bf16_t*)(a->ws + WS_Z);
    bf16_t* QB = (bf16_t*)(a->ws + WS_QB); bf16_t* KB = (bf16_t*)(a->ws + WS_KB); bf16_t* VB = (bf16_t*)(a->ws + WS_VB);
    bf16_t* QC = (bf16_t*)(a->ws + WS_QC); bf16_t* CKVN = (bf16_t*)(a->ws + WS_CKVN); float* KR = (float*)(a->ws + WS_KR);
    const int lane = c.lane;
    const int half = lane >> 5; const bool isx1 = (lane & 16) == 0; const int ib = 2 * (lane & 15);
    const float inv128_0 = __builtin_amdgcn_exp2f(-(float)ib * (L2_10000 / 32.f)), inv128_1 = __builtin_amdgcn_exp2f(-(float)(ib + 1) * (L2_10000 / 32.f));
    const f32x2 gq = *(const f32x2*)(a->in[14] + l * 128 + 2 * lane), gk = *(const f32x2*)(a->in[15] + l * 128 + 2 * lane);
    const int halfc = (lane >> 4) & 1; const bool isx1c = (lane & 8) == 0; const int ibc = 2 * (lane & 7);
    const float inv64_0 = __builtin_amdgcn_exp2f(-(float)ibc * (L2_10000 / 16.f)), inv64_1 = __builtin_amdgcn_exp2f(-(float)(ibc + 1) * (L2_10000 / 16.f));
    const f32x2 gcn = *(const f32x2*)(a->in[17] + l * 192 + 2 * lane);
    const f32x2 gcr = lane < 32 ? *(const f32x2*)(a->in[17] + l * 192 + 128 + 2 * lane) : (f32x2){0.f, 0.f};
    const f32x4 gkv0 = *(const f32x4*)(a->in[16] + l * 512 + lane * 8), gkv1 = *(const f32x4*)(a->in[16] + l * 512 + lane * 8 + 4);
    const bool zsplit = c.G * NWAVES > 512 + 64;
    if (zsplit && c.wave < 2) return;
    const int zgw = zsplit ? c.bx * 6 + (c.wave - 2) : c.gw, zn = zsplit ? c.G * 6 : c.NGW;
    for (int r = zgw; r < NTOK + 4096; r += zn) {
        if (r >= NTOK) {
            const int q = r - NTOK, b = q >> 9, t = q & 511; const size_t kvrow = 8192 + (size_t)b * 1536 + t; const size_t crow_ = ((size_t)(b * 2 + l) * 512 + t);
            const f32x4 kk = *(const f32x4*)(a->in[2] + crow_ * 256 + lane * 4), vv = *(const f32x4*)(a->in[3] + crow_ * 256 + lane * 4);
            const f32x4 c0 = *(const f32x4*)(a->in[4] + crow_ * 512 + lane * 8), c1 = *(const f32x4*)(a->in[4] + crow_ * 512 + lane * 8 + 4);
            const float krv = a->in[5][crow_ * 64 + lane];
            u32x2 w; w.x = pk2(kk.x, kk.y); w.y = pk2(kk.z, kk.w); *(u32x2*)(KB + kvrow * 256 + lane * 4) = w;
            w.x = pk2(vv.x, vv.y); w.y = pk2(vv.z, vv.w); *(u32x2*)(VB + kvrow * 256 + lane * 4) = w;
            u32x4 w4; w4.x = pk2(c0.x, c0.y); w4.y = pk2(c0.z, c0.w); w4.z = pk2(c1.x, c1.y); w4.w = pk2(c1.z, c1.w); *(u32x4*)(CKVN + kvrow * 512 + lane * 8) = w4;
            KR[kvrow * 64 + lane] = krv;
            continue;
        }
        const bf16_t* z = Z + (size_t)r * INWP;
        const bool lat = r >= NCTXR;
        int b, t; size_t kvrow;
        if (!lat) { b = r >> 8; t = r & 255; kvrow = r; } else { const int q = r - NCTXR; b = q >> 10; t = q & 1023; kvrow = 8192 + (size_t)b * 1536 + 512 + t; }
        const size_t orow = ((size_t)(b * 2 + l) * 256 + t);
        unsigned zq[6], zk[2], zv[2], zc[6], zr[6];
#pragma unroll
        for (int hh = 0; hh < 6; ++hh) { zq[hh] = *(const unsigned*)(z + ZQB + hh * 128 + 2 * lane); zc[hh] = *(const unsigned*)(z + ZQC + hh * 192 + 2 * lane);
            zr[hh] = 0u; if (lane < 32) zr[hh] = *(const unsigned*)(z + ZQC + hh * 192 + 128 + 2 * lane); }
#pragma unroll
        for (int kh = 0; kh < 2; ++kh) { zk[kh] = *(const unsigned*)(z + ZKB + kh * 128 + 2 * lane); zv[kh] = *(const unsigned*)(z + ZVB + kh * 128 + 2 * lane); }
        const u32x4 raw = *(const u32x4*)(z + ZCKV + lane * 8); unsigned zkr = 0u; if (lane < 32) zkr = *(const unsigned*)(z + ZKR + 2 * lane);
        asm volatile("" ::: "memory");
        float cs0 = 1.f, sn0 = 0.f, cs1 = 1.f, sn1 = 0.f, c60 = 1.f, s60 = 0.f, c61 = 1.f, s61 = 0.f;
        if (lat) { const float pos = half ? (float)(t & 63) : (float)(t >> 6); cs0 = __cosf(pos * inv128_0); sn0 = __sinf(pos * inv128_0); cs1 = __cosf(pos * inv128_1); sn1 = __sinf(pos * inv128_1);
                   const float pc = halfc ? (float)(t & 63) : (float)(t >> 6); c60 = __cosf(pc * inv64_0); s60 = __sinf(pc * inv64_0); c61 = __cosf(pc * inv64_1); s61 = __sinf(pc * inv64_1); }
        if (!isx1) { sn0 = -sn0; sn1 = -sn1; }
        if (!isx1c) { s60 = -s60; s61 = -s61; }
#pragma unroll
        for (int hh = 0; hh < 6; ++hh) { const float v0 = lo_bf(zq[hh]), v1 = hi_bf(zq[hh]);
            const float rs = rsqrtf(wave_sum(v0 * v0 + v1 * v1) * (1.f / 128.f) + EPSN); const float n0 = v0 * rs * gq.x, n1 = v1 * rs * gq.y;
            const float p0 = swz16(n0), p1 = swz16(n1);
            *(unsigned*)(QB + (size_t)r * 768 + hh * 128 + 2 * lane) = pk2(n0 * cs0 - p0 * sn0, n1 * cs1 - p1 * sn1); }
#pragma unroll
        for (int kh = 0; kh < 2; ++kh) { const float v0 = lo_bf(zk[kh]), v1 = hi_bf(zk[kh]);
            const float rs = rsqrtf(wave_sum(v0 * v0 + v1 * v1) * (1.f / 128.f) + EPSN); const float n0 = v0 * rs * gk.x, n1 = v1 * rs * gk.y;
            const float p0 = swz16(n0), p1 = swz16(n1);
            *(unsigned*)(KB + kvrow * 256 + kh * 128 + 2 * lane) = pk2(n0 * cs0 - p0 * sn0, n1 * cs1 - p1 * sn1);
            *(unsigned*)(VB + kvrow * 256 + kh * 128 + 2 * lane) = zv[kh];
            if (!lat) { *(f32x2*)(a->out + O_K + orow * 256 + kh * 128 + 2 * lane) = (f32x2){n0, n1};
                        *(f32x2*)(a->out + O_V + orow * 256 + kh * 128 + 2 * lane) = (f32x2){lo_bf(zv[kh]), hi_bf(zv[kh])}; } }
#pragma unroll
        for (int hh = 0; hh < 6; ++hh) { const float va = lo_bf(zc[hh]), vb = hi_bf(zc[hh]), q0 = lo_bf(zr[hh]), q1 = hi_bf(zr[hh]);
            const float rs = rsqrtf(wave_sum(va * va + vb * vb + q0 * q0 + q1 * q1) * (1.f / 192.f) + EPSN);
            bf16_t* qo = QC + (size_t)r * 1152 + hh * 192;
            *(unsigned*)(qo + 2 * lane) = pk2(va * rs * gcn.x, vb * rs * gcn.y);
            const float n0 = q0 * rs * gcr.x, n1 = q1 * rs * gcr.y; const float p0 = swz8(n0), p1 = swz8(n1);
            if (lane < 32) *(unsigned*)(qo + 128 + 2 * lane) = pk2(n0 * c60 - p0 * s60, n1 * c61 - p1 * s61); }
        { float x[8];
          x[0] = lo_bf(raw.x); x[1] = hi_bf(raw.x); x[2] = lo_bf(raw.y); x[3] = hi_bf(raw.y); x[4] = lo_bf(raw.z); x[5] = hi_bf(raw.z); x[6] = lo_bf(raw.w); x[7] = hi_bf(raw.w);
          float sq = 0.f;
#pragma unroll
          for (int j = 0; j < 8; ++j) sq += x[j] * x[j];
          const float rs = rsqrtf(wave_sum(sq) * (1.f / 512.f) + EPSN);
          const f32x4 y0 = (f32x4){x[0], x[1], x[2], x[3]} * rs * gkv0, y1 = (f32x4){x[4], x[5], x[6], x[7]} * rs * gkv1;
          u32x4 w4; w4.x = pk2(y0.x, y0.y); w4.y = pk2(y0.z, y0.w); w4.z = pk2(y1.x, y1.y); w4.w = pk2(y1.z, y1.w); *(u32x4*)(CKVN + kvrow * 512 + lane * 8) = w4;
          if (!lat) { *(f32x4*)(a->out + O_CKV + orow * 512 + lane * 8) = y0; *(f32x4*)(a->out + O_CKV + orow * 512 + lane * 8 + 4) = y1; } }
        if (lane < 32) { const f32x2 kv = (f32x2){lo_bf(zkr), hi_bf(zkr)}; *(f32x2*)(KR + kvrow * 64 + 2 * lane) = kv; if (!lat) *(f32x2*)(a->out + O_KRO + orow * 64 + 2 * lane) = kv; }
    }
}

__device__ __forceinline__ float lcst(float v) { asm volatile("" : "+v"(v)); return v; }
__device__ __forceinline__ void sincos_acc(float x, float& s, float& c) {
    const float k = rintf(x * 0.636619772367581343f);
    float r = fmaf(-k, 1.5703125f, x); r = fmaf(-k, 4.837512969970703125e-4f, r); r = fmaf(-k, 7.54978995489188e-8f, r);
    const float r2 = r * r;
    const float sr = fmaf(r * r2, fmaf(r2, fmaf(r2, lcst(-1.9515295891e-4f), lcst(8.3321608736e-3f)), lcst(-1.6666654611e-1f)), r);
    const float cr = fmaf(r2 * r2, fmaf(r2, fmaf(r2, lcst(2.443315711809948e-5f), lcst(-1.388731625493765e-3f)), lcst(4.166664568298827e-2f)), fmaf(r2, -0.5f, 1.0f));
    const int q = ((int)k) & 3;
    s = (q == 0) ? sr : (q == 1) ? cr : (q == 2) ? -sr : -cr;
    c = (q == 0) ? cr : (q == 1) ? -sr : (q == 2) ? -cr : sr;
}
constexpr int S5_HROW = 272;
constexpr int S5_BUROW = 528;
constexpr int S5_WLDS = 16 * S5_BUROW + 16 * S5_HROW;
__device__ __forceinline__ void s5_item(AP a, int l, int seq, int dir, int g, LAS unsigned char* wl, int lane) {
    const bool lat = seq >= 32; const int T = lat ? 1024 : 256; const int row0 = lat ? NCTXR + (seq - 32) * 1024 : seq * 256;
    const int pidx = (l * 2 + dir) * 32 + g;
    const bf16_t* Z = (const bf16_t*)(a->ws + WS_Z);
    float* Yd = (float*)(a->ws + (dir ? WS_YB : WS_YF));
    float lbr, lbi, cr, ci;
    { const float lr = a->in[21][pidx * 64 + lane], li = a->in[22][pidx * 64 + lane]; const float dt = expf(a->in[23][pidx]);
      const float ang = li * dt; float sn, cs, sh, ch; sincos_acc(ang, sn, cs); sincos_acc(0.5f * ang, sh, ch);
      const float em1 = expm1f(lr * dt), mag = em1 + 1.f;
      lbr = mag * cs; lbi = mag * sn;
      const float nr = em1 - 2.f * mag * sh * sh, ni = lbi, den = lr * lr + li * li; cr = (nr * lr + ni * li) / den; ci = (ni * lr - nr * li) / den; }
    bf16x8 ahi[8], alo[8];
    { const int ri = lane & 1, cb = 8 * ((lane >> 4) & 1); const bool act = lane < 32;
#pragma unroll
      for (int m = 0; m < 8; ++m) { const int pm = 8 * m + ((lane & 15) >> 1);
          const float crm = __shfl(cr, pm), cim = __shfl(ci, pm);
          const f32x4* bre = (const f32x4*)(a->in[24] + ((size_t)pidx * 64 + pm) * 16 + cb); const f32x4* bim = (const f32x4*)(a->in[25] + ((size_t)pidx * 64 + pm) * 16 + cb);
          float v[8];
#pragma unroll
          for (int j = 0; j < 2; ++j) { const f32x4 br = bre[j], bi = bim[j];
#pragma unroll
              for (int e = 0; e < 4; ++e) v[j * 4 + e] = act ? (ri ? crm * bi[e] + cim * br[e] : crm * br[e] - cim * bi[e]) : 0.f; }
          unsigned h[8], lo[8];
#pragma unroll
          for (int e = 0; e < 8; ++e) { h[e] = f2bf(v[e]); lo[e] = f2bf(v[e] - bf2f((unsigned short)h[e])); }
          u32x4 wh, wlw; wh.x = h[0] | (h[1] << 16); wh.y = h[2] | (h[3] << 16); wh.z = h[4] | (h[5] << 16); wh.w = h[6] | (h[7] << 16);
          wlw.x = lo[0] | (lo[1] << 16); wlw.y = lo[2] | (lo[3] << 16); wlw.z = lo[4] | (lo[5] << 16); wlw.w = lo[6] | (lo[7] << 16);
          ahi[m] = __builtin_bit_cast(bf16x8, wh); alo[m] = __builtin_bit_cast(bf16x8, wlw); } }
    bf16x8 cf[4];
    { const int cc = lane & 15;
#pragma unroll
      for (int kb = 0; kb < 4; ++kb) { const int p0 = 16 * kb + 4 * (lane >> 4);
          const f32x4 c_r = *(const f32x4*)(a->in[26] + ((size_t)pidx * 16 + cc) * 64 + p0), c_i = *(const f32x4*)(a->in[27] + ((size_t)pidx * 16 + cc) * 64 + p0);
          u32x4 w; w.x = pk2(c_r.x, -c_i.x); w.y = pk2(c_r.y, -c_i.y); w.z = pk2(c_r.z, -c_i.z); w.w = pk2(c_r.w, -c_i.w); cf[kb] = __builtin_bit_cast(bf16x8, w); } }
    float hr = 0.f, hi = 0.f;
    if (lat) { const f32x2 h0 = *(const f32x2*)(a->in[6] + (((((size_t)(seq - 32) * 2 + l) * 2 + dir) * 32 + g) * 64 + lane) * 2); hr = h0.x; hi = h0.y; }
    LAS unsigned char* BU = wl; LAS unsigned char* H = wl + 16 * S5_BUROW;
    const int ut = lane & 15, uh = (lane >> 4) & 1;
    auto urow = [&](int n) { return (size_t)(row0 + (dir ? T - 1 - n : n)); };
    u32x4 ureg = (u32x4){0u, 0u, 0u, 0u}, unext = (u32x4){0u, 0u, 0u, 0u};
    if (lane < 32) ureg = *(const u32x4*)(Z + urow(ut) * INWP + ZU + g * 16 + uh * 8);
    const int nch = T / 16;
    for (int ci_ = 0; ci_ < nch; ++ci_) {
        if (ci_ + 1 < nch && lane < 32) unext = *(const u32x4*)(Z + urow(16 * (ci_ + 1) + ut) * INWP + ZU + g * 16 + uh * 8);
        const bf16x8 ub = __builtin_bit_cast(bf16x8, ureg);
#pragma unroll
        for (int m = 0; m < 8; ++m) { f32x4 d = __builtin_amdgcn_mfma_f32_16x16x32_bf16(ahi[m], ub, (f32x4){0.f, 0.f, 0.f, 0.f}, 0, 0, 0);
            d = __builtin_amdgcn_mfma_f32_16x16x32_bf16(alo[m], ub, d, 0, 0, 0);
            *(LAS f32x4*)(BU + (lane & 15) * S5_BUROW + (16 * m + 4 * (lane >> 4)) * 4) = d; }
        asm volatile("" ::: "memory");
#pragma unroll
        for (int s = 0; s < 16; ++s) {
            const f32x2 b = *(const LAS f32x2*)(BU + s * S5_BUROW + lane * 8);
            const float nr = lbr * hr - lbi * hi + b.x, ni = lbr * hi + lbi * hr + b.y; hr = nr; hi = ni;
            *(LAS unsigned*)(H + s * S5_HROW + lane * 4) = pk2(hr, hi);
        }
        asm volatile("" ::: "memory");
        f32x4 acc = (f32x4){0.f, 0.f, 0.f, 0.f};
#pragma unroll
        for (int kb = 0; kb < 4; ++kb) { const bf16x8 hb = *(const LAS bf16x8*)(H + (lane & 15) * S5_HROW + (16 * kb + 4 * (lane >> 4)) * 4);
            acc = __builtin_amdgcn_mfma_f32_16x16x32_bf16(cf[kb], hb, acc, 0, 0, 0); }
        *(f32x4*)(Yd + ((size_t)g * NTOK + urow(16 * ci_ + (lane & 15))) * 16 + 4 * (lane >> 4)) = acc;
        asm volatile("" ::: "memory");
        ureg = unext;
    }
    if (!lat) { *(f32x2*)(a->out + O_SSM + (((((size_t)seq * 2 + l) * 2 + dir) * 32 + g) * 64 + lane) * 2) = (f32x2){hr, hi}; }
}
__device__ __forceinline__ void s5_phase(AP a, const Ctx& c, int l, LAS unsigned char* lds) {
    LAS unsigned char* wl = lds + c.wave * S5_WLDS;
    const int slot = c.wave * c.G + c.bx, nslots = NWAVES * c.G;
    if (nslots > 512 + 64) {
        if (slot < 512) { const int it = slot; s5_item(a, l, 32 + it / 64, (it % 64) >> 5, it & 31, wl, c.lane); }
        else { for (int j = slot - 512; j < 2048; j += nslots - 512) s5_item(a, l, j / 64, (j % 64) >> 5, j & 31, wl, c.lane); }
    } else {
        for (int it = slot; it < 2560; it += nslots) { int seq, rem; if (it < 512) { seq = 32 + it / 64; rem = it % 64; } else { const int j = it - 512; seq = j / 64; rem = j % 64; }
            s5_item(a, l, seq, rem >> 5, rem & 31, wl, c.lane); }
    }
}

__device__ __forceinline__ void knorm_combine(AP a, const Ctx& c, int l) {
    const bf16_t* KVRAW = (const bf16_t*)(a->ws + WS_KVRAW); const float* KR = (const float*)(a->ws + WS_KR); bf16_t* KC = (bf16_t*)(a->ws + WS_KC);
    const int lane = c.lane;
    const int halfc = (lane >> 4) & 1; const bool isx1c = (lane & 8) == 0; const int ibc = 2 * (lane & 7);
    const float inv64_0 = __builtin_amdgcn_exp2f(-(float)ibc * (L2_10000 / 16.f)), inv64_1 = __builtin_amdgcn_exp2f(-(float)(ibc + 1) * (L2_10000 / 16.f));
    const f32x2 gn = *(const f32x2*)(a->in[18] + l * 192 + 2 * lane);
    const f32x2 gr = lane < 32 ? *(const f32x2*)(a->in[18] + l * 192 + 128 + 2 * lane) : (f32x2){0.f, 0.f};
    unsigned kkn[6]; f32x2 krn = (f32x2){0.f, 0.f};
    if (c.gw < KVROWS) { const bf16_t* kn = KVRAW + (size_t)c.gw * 1536;
#pragma unroll
        for (int hh = 0; hh < 6; ++hh) kkn[hh] = *(const unsigned*)(kn + hh * 128 + 2 * lane);
        if (lane < 32) krn = *(const f32x2*)(KR + (size_t)c.gw * 64 + 2 * lane); }
    for (int r = c.gw; r < KVROWS; r += c.NGW) {
        bool isnew = false; int t = 0;
        if (r >= 8192) { const int q = (r - 8192) % 1536; if (q >= 512) { isnew = true; t = q - 512; } }
        unsigned kk[6]; f32x2 kr2 = krn;
#pragma unroll
        for (int hh = 0; hh < 6; ++hh) kk[hh] = kkn[hh];
        if (r + c.NGW < KVROWS) { const bf16_t* kn = KVRAW + (size_t)(r + c.NGW) * 1536;
#pragma unroll
            for (int hh = 0; hh < 6; ++hh) kkn[hh] = *(const unsigned*)(kn + hh * 128 + 2 * lane);
            if (lane < 32) krn = *(const f32x2*)(KR + (size_t)(r + c.NGW) * 64 + 2 * lane); }
        asm volatile("" ::: "memory");
        float c60 = 1.f, s60 = 0.f, c61 = 1.f, s61 = 0.f;
        if (isnew) { const float pc = halfc ? (float)(t & 63) : (float)(t >> 6); c60 = __cosf(pc * inv64_0); s60 = __sinf(pc * inv64_0); c61 = __cosf(pc * inv64_1); s61 = __sinf(pc * inv64_1); }
        if (!isx1c) { s60 = -s60; s61 = -s61; }
        const float sskr = wave_sum(kr2.x * kr2.x + kr2.y * kr2.y);
#pragma unroll
        for (int hh = 0; hh < 6; ++hh) { const float va = lo_bf(kk[hh]), vb = hi_bf(kk[hh]);
            const float rs = rsqrtf((wave_sum(va * va + vb * vb) + sskr) * (1.f / 192.f) + EPSN);
            bf16_t* ko = KC + (size_t)r * 1152 + hh * 192;
            *(unsigned*)(ko + 2 * lane) = pk2(va * rs * gn.x, vb * rs * gn.y);
            const float n0 = kr2.x * rs * gr.x, n1 = kr2.y * rs * gr.y; const float p0 = swz8(n0), p1 = swz8(n1);
            if (lane < 32) *(unsigned*)(ko + 128 + 2 * lane) = pk2(n0 * c60 - p0 * s60, n1 * c61 - p1 * s61); }
    }
    const bf16_t* Z = (const bf16_t*)(a->ws + WS_Z); const float* YF = (const float*)(a->ws + WS_YF); const float* YB = (const float*)(a->ws + WS_YB); bf16_t* Y = (bf16_t*)(a->ws + WS_Y);
    const f32x4 d0 = *(const f32x4*)(a->in[28] + l * 512 + lane * 8), d1 = *(const f32x4*)(a->in[28] + l * 512 + lane * 8 + 4);
    for (int r = c.gw; r < NTOK; r += c.NGW) {
        const u32x4 raw = *(const u32x4*)(Z + (size_t)r * INWP + ZU + lane * 8);
        const f32x4 u0 = (f32x4){__builtin_bit_cast(float, raw.x << 16), __builtin_bit_cast(float, raw.x & 0xffff0000u), __builtin_bit_cast(float, raw.y << 16), __builtin_bit_cast(float, raw.y & 0xffff0000u)};
        const f32x4 u1 = (f32x4){__builtin_bit_cast(float, raw.z << 16), __builtin_bit_cast(float, raw.z & 0xffff0000u), __builtin_bit_cast(float, raw.w << 16), __builtin_bit_cast(float, raw.w & 0xffff0000u)};
        const size_t yo = ((size_t)(lane >> 1) * NTOK + r) * 16 + (lane & 1) * 8;
        const f32x4 f0 = *(const f32x4*)(YF + yo), f1 = *(const f32x4*)(YF + yo + 4);
        const f32x4 b0 = *(const f32x4*)(YB + yo), b1 = *(const f32x4*)(YB + yo + 4);
        const f32x4 y0 = d0 * u0 + f0 + b0, y1 = d1 * u1 + f1 + b1;
        u32x4 w; w.x = pk2(y0.x, y0.y); w.y = pk2(y0.z, y0.w); w.z = pk2(y1.x, y1.y); w.w = pk2(y1.z, y1.w); *(u32x4*)(Y + (size_t)r * 512 + lane * 8) = w;
    }
}

template <bool MLA>
__device__ __forceinline__ void attn_unit_run(AP a, int u, char* lds, const int tid) {
    int seq, h, qb;
    if (u < 192) { seq = 32 + u / 24; h = (u % 24) >> 2; qb = u & 3; } else { const int j = u - 192; seq = j / 6; h = j % 6; qb = 0; }
    const bool lat = seq >= 32;
    const size_t qrow = lat ? NCTXR + (size_t)(seq - 32) * 1024 + qb * 256 : (size_t)seq * 256;
    const size_t kvrow = lat ? 8192 + (size_t)(seq - 32) * 1536 : (size_t)seq * 256;
    const int nkeys = lat ? 1536 : 256;
    bf16_t* MIX = (bf16_t*)(a->ws + WS_MIX);
    if constexpr (!MLA) {
        const bf16_t* Q = (const bf16_t*)(a->ws + WS_QB) + qrow * 768 + h * 128;
        const bf16_t* K = (const bf16_t*)(a->ws + WS_KB) + kvrow * 256 + (h / 3) * 128;
        const bf16_t* V = (const bf16_t*)(a->ws + WS_VB) + kvrow * 256 + (h / 3) * 128;
        att::attn_body<128, 768, 256, 256>(Q, K, V, MIX + qrow * 2048 + 512 + h * 128, nkeys, lds, tid);
    } else {
        const bf16_t* Q = (const bf16_t*)(a->ws + WS_QC) + qrow * 1152 + h * 192;
        const bf16_t* K = (const bf16_t*)(a->ws + WS_KC) + kvrow * 1152 + h * 192;
        const bf16_t* V = (const bf16_t*)(a->ws + WS_KVRAW) + kvrow * 1536 + 768 + h * 128;
        att::attn_body<192, 1152, 1152, 1536>(Q, K, V, MIX + qrow * 2048 + 1280 + h * 128, nkeys, lds, tid);
    }
}
template <bool MLA>
__device__ __forceinline__ void attn_phase(AP a, const Ctx& c, char* lds) {
    const int bx = c.vc;
    int u0, du, nu;
    if (c.G == 256) { if (bx < 192) { u0 = bx; du = 1; nu = 1; } else { u0 = 192 + 3 * (bx - 192); du = 1; nu = 3; } }
    else { u0 = bx; du = c.G; nu = (384 - bx + c.G - 1) / c.G; }
#pragma unroll 1
    for (int k = 0; k < nu; ++k) attn_unit_run<MLA>(a, u0 + k * du, lds, c.tid);
}

__global__ void __launch_bounds__(NTHR, 2) fwd_megakernel(Args kargs_unused) {
    extern __shared__ __attribute__((aligned(16))) unsigned char lds_raw[];
    cg::grid_group grid = cg::this_grid();
    LAS unsigned char* lds = (LAS unsigned char*)lds_raw;
    Ctx c;
    AP a = (AP)__builtin_amdgcn_kernarg_segment_ptr();
    const int wave_id0 = __builtin_amdgcn_readfirstlane((int)threadIdx.x >> 6);
#define PHASE_BEGIN() do { int w_ = wave_id0; asm volatile("" : "+s"(w_)); int ln_; asm volatile("v_mbcnt_lo_u32_b32 %0, -1, 0\n\tv_mbcnt_hi_u32_b32 %0, -1, %0" : "=v"(ln_)); \
        int b_ = blockIdx.x; asm volatile("" : "+s"(b_)); int g_ = gridDim.x; asm volatile("" : "+s"(g_)); \
        c.tid = w_ * 64 + ln_; c.lane = ln_; c.wave = w_; c.G = g_; c.bx = b_; c.gw = b_ * NWAVES + w_; c.NGW = g_ * NWAVES; asm volatile("" : "+s"(a)); \
        c.xp = __builtin_amdgcn_readfirstlane((int)((volatile LAS unsigned*)(lds + 131072))[0]); c.xn = __builtin_amdgcn_readfirstlane((int)((volatile LAS unsigned*)(lds + 131072))[1]); \
        c.xr = __builtin_amdgcn_readfirstlane((int)((volatile LAS unsigned*)(lds + 131072))[2]); c.vc = c.xp + c.xr; } while (0)
#define GRID_SYNC() do { asm volatile("s_waitcnt vmcnt(0) lgkmcnt(0)" ::: "memory"); grid.sync(); \
        if (wave_id0 == 0) { __builtin_amdgcn_fence(__ATOMIC_ACQUIRE, "agent"); asm volatile("s_waitcnt vmcnt(0)" ::: "memory"); } \
        __syncthreads(); } while (0)
    unsigned nbar = 0u;
#define XB_SYNC() do { asm volatile("s_waitcnt vmcnt(0) lgkmcnt(0)" ::: "memory"); __syncthreads(); \
        if (threadIdx.x == 0) { volatile LAS unsigned* mz_ = (volatile LAS unsigned*)(lds + 131072); const unsigned x_ = mz_[4], nx_ = mz_[5], nloc_ = mz_[6]; \
            AP a2_ = a; asm volatile("" : "+s"(a2_)); unsigned* xb_ = (unsigned*)(a2_->ws + WS_XB); \
            const unsigned old_ = __hip_atomic_fetch_add(xb_ + 64u * x_, 1u, __ATOMIC_RELAXED, __HIP_MEMORY_SCOPE_AGENT); \
            if (old_ + 1u == (nbar + 1u) * nloc_) { \
                __builtin_amdgcn_fence(__ATOMIC_RELEASE, "agent"); asm volatile("s_waitcnt vmcnt(0)" ::: "memory"); \
                const unsigned og_ = __hip_atomic_fetch_add(xb_ + 2048, 1u, __ATOMIC_RELAXED, __HIP_MEMORY_SCOPE_AGENT); \
                if (og_ + 1u == (nbar + 1u) * nx_) (void)__hip_atomic_fetch_add(xb_ + 2112, 1u, __ATOMIC_RELAXED, __HIP_MEMORY_SCOPE_AGENT); \
                else while (__hip_atomic_load(xb_ + 2112, __ATOMIC_RELAXED, __HIP_MEMORY_SCOPE_AGENT) == nbar) __builtin_amdgcn_s_sleep(1); \
                __builtin_amdgcn_fence(__ATOMIC_ACQUIRE, "agent"); \
                (void)__hip_atomic_fetch_add(xb_ + 1024u + 64u * x_, 1u, __ATOMIC_RELAXED, __HIP_MEMORY_SCOPE_AGENT); asm volatile("s_waitcnt vmcnt(0)" ::: "memory"); \
            } else { \
                while (__hip_atomic_load(xb_ + 1024u + 64u * x_, __ATOMIC_RELAXED, __HIP_MEMORY_SCOPE_AGENT) == nbar) __builtin_amdgcn_s_sleep(1); \
                __builtin_amdgcn_fence(__ATOMIC_ACQUIRE, "agent"); asm volatile("s_waitcnt vmcnt(0)" ::: "memory"); } } \
        nbar += 1u; __syncthreads(); } while (0)
    PHASE_BEGIN();

#ifndef PH
#define PH 0xFFFF
#endif
#if PH & 1
    if (blockIdx.x == 0 && threadIdx.x < 16) ((unsigned*)(a->ws + WS_CEN))[threadIdx.x] = 0u;
    if (blockIdx.x == 0) for (int i = threadIdx.x; i < 2176; i += NTHR) ((unsigned*)(a->ws + WS_XB))[i] = 0u;
    phase0(a, c, lds);
#endif
    GRID_SYNC(); PHASE_BEGIN();
    { volatile LAS unsigned* misc = (volatile LAS unsigned*)(lds + 131072);
      if (c.tid == 0) { unsigned* cen = (unsigned*)(a->ws + WS_CEN); const unsigned x = (unsigned)__builtin_amdgcn_s_getreg((3 << 11) | 20) & 0xFu;
          misc[2] = x; misc[3] = __hip_atomic_fetch_add(cen + x, 1u, __ATOMIC_RELAXED, __HIP_MEMORY_SCOPE_AGENT); }
      GRID_SYNC();
      if (threadIdx.x == 0) { unsigned* cen = (unsigned*)(a->ws + WS_CEN); const unsigned x = misc[2], rank = misc[3]; unsigned pre = 0u, mine = 1u, tot = 0u;
          for (unsigned j = 0; j < 16; ++j) { const unsigned v = __hip_atomic_load(cen + j, __ATOMIC_RELAXED, __HIP_MEMORY_SCOPE_AGENT); tot += v; if (j < x) pre += v; if (j == x) mine = v; }
          if (tot != gridDim.x || rank >= mine) { pre = blockIdx.x; mine = 1u; }
          unsigned nxp = 0u; for (unsigned j = 0; j < 16; ++j) nxp += __hip_atomic_load(cen + j, __ATOMIC_RELAXED, __HIP_MEMORY_SCOPE_AGENT) ? 1u : 0u;
          const bool bad = (tot != gridDim.x || rank >= mine);
          misc[0] = pre; misc[1] = mine; misc[2] = bad ? 0u : rank; misc[4] = x; misc[5] = bad ? 0u : nxp; misc[6] = bad ? 1u : mine; }
      __syncthreads(); PHASE_BEGIN(); }

    const bool use_xb = __builtin_amdgcn_readfirstlane((int)((volatile LAS unsigned*)(lds + 131072))[5]) != 0;
#define SEAM() do { if (use_xb) XB_SYNC(); else GRID_SYNC(); } while (0)
#pragma unroll
    for (int l = 0; l < 2; ++l) {
        const bool first = (l == 0);
#define WLP (a->ws + WS_W + (size_t)l * WL_SIZE)
#if PH & 2
        phase_norm(a, c, l, 0, first);
#endif
        SEAM(); PHASE_BEGIN();
#if PH & 4
        { pg8::Gemm g{(const bf16_t*)(a->ws + WS_HN), (const bf16_t*)(WLP + WL_IN), NTOK, INWP, DM}; pg8::StaticOrder S; S.init(NTOK, INWP, c.G, c.xp, c.xn, c.xr);
          pg8::EpiBf16<0> E{(bf16_t*)(a->ws + WS_Z), INWP};
          pg8::gemm_phase<pg8::EpiBf16<0>, pg8::StaticOrder, true, true>(lds, g, S, E, c.tid); }
        SEAM(); PHASE_BEGIN();
#endif
#if PH & 8
        s5_phase(a, c, l, lds);
#endif
        PHASE_BEGIN();
#if PH & 16
        zpost_rows(a, c, l);
#endif
        SEAM(); PHASE_BEGIN();
#if PH & 32
        { pg8::Gemm g{(const bf16_t*)(a->ws + WS_CKVN), (const bf16_t*)(WLP + WL_UKV), KVROWS, 1536, 512}; pg8::StaticOrder S; S.init(KVROWS, 1536, c.G, c.xp, c.xn, c.xr);
          pg8::EpiBf16<0> E{(bf16_t*)(a->ws + WS_KVRAW), 1536};
          pg8::gemm_phase<pg8::EpiBf16<0>, pg8::StaticOrder, true, true>(lds, g, S, E, c.tid); }
#endif
        __syncthreads(); PHASE_BEGIN();
#if PH & 64
        attn_phase<false>(a, c, (char*)lds_raw);
#endif
        SEAM(); PHASE_BEGIN();
#if PH & 128
        knorm_combine(a, c, l);
#endif
        SEAM(); PHASE_BEGIN();
#if PH & 256
        attn_phase<true>(a, c, (char*)lds_raw);
#endif
        __syncthreads(); PHASE_BEGIN();
#if PH & 512
        { pg8::Gemm g{(const bf16_t*)(a->ws + WS_Y), (const bf16_t*)(WLP + WL_GLU), NTOK, 1024, 512}; pg8::StaticOrder S; S.init(NTOK, 1024, c.G, c.xp, c.xn, c.xr);
          pg8::EpiGlu E{(bf16_t*)(a->ws + WS_MIX), DM};
          pg8::gemm_phase<pg8::EpiGlu, pg8::StaticOrder, true, true>(lds, g, S, E, c.tid); }
        SEAM(); PHASE_BEGIN();
#endif
#if PH & 1024
        { pg8::Gemm g{(const bf16_t*)(a->ws + WS_MIX), (const bf16_t*)(WLP + WL_OUT), NTOK, DM, DM}; pg8::StaticOrder S; S.init(NTOK, DM, c.G, c.xp, c.xn, c.xr);
          pg8::EpiResGate E{first ? a->in[0] : a->out, first ? a->in[1] : a->out + (size_t)NCTXR * DM, a->out, (const float*)(a->ws + WS_MOD) + (size_t)l * 9 * 12288 + 2 * DM};
          pg8::gemm_phase<pg8::EpiResGate, pg8::StaticOrder, true, true>(lds, g, S, E, c.tid); }
        SEAM(); PHASE_BEGIN();
#endif
#if PH & 2048
        phase_norm(a, c, l, 1, false);
#endif
        SEAM(); PHASE_BEGIN();
#if PH & 4096
        { pg8::Gemm g{(const bf16_t*)(a->ws + WS_HN), (const bf16_t*)(WLP + WL_FF1), NTOK, DFF, DM}; pg8::StaticOrder S; S.init(NTOK, DFF, c.G, c.xp, c.xn, c.xr);
          pg8::EpiBf16<2> E{(bf16_t*)(a->ws + WS_HFF), DFF};
          pg8::gemm_phase<pg8::EpiBf16<2>, pg8::StaticOrder, true, true>(lds, g, S, E, c.tid); }
        SEAM(); PHASE_BEGIN();
#endif
#if PH & 8192
        { pg8::Gemm g{(const bf16_t*)(a->ws + WS_HFF), (const bf16_t*)(WLP + WL_FF2), NTOK, DM, DFF}; pg8::StaticOrder S; S.init(NTOK, DM, c.G, c.xp, c.xn, c.xr);
          pg8::EpiResGate E{a->out, a->out + (size_t)NCTXR * DM, a->out, (const float*)(a->ws + WS_MOD) + (size_t)l * 9 * 12288 + 5 * DM};
          pg8::gemm_phase<pg8::EpiResGate, pg8::StaticOrder, true, true>(lds, g, S, E, c.tid); }
#endif
        if (l == 0) { SEAM(); PHASE_BEGIN(); }
    }
}

extern "C" void kernel_launch(void* const* d_in, const int* in_sizes, int n_in, void* d_out, int out_size, void* d_ws, size_t ws_size, hipStream_t stream) {
    static int grid_blocks = 0;
    if (grid_blocks == 0) {
        if (n_in != 33 || ws_size < WS_END) { fprintf(stderr, "kernel_launch: unexpected n_in %d / ws_size %zu (need %zu)\n", n_in, ws_size, (size_t)WS_END); grid_blocks = -1; return; }
        int dev = 0, cus = 0, per_cu = 0;
        hipGetDevice(&dev);
        hipDeviceGetAttribute(&cus, hipDeviceAttributeMultiprocessorCount, dev);
        if (hipFuncSetAttribute((const void*)fwd_megakernel, hipFuncAttributeMaxDynamicSharedMemorySize, LDS_BYTES) != hipSuccess) { fprintf(stderr, "kernel_launch: hipFuncSetAttribute failed\n"); grid_blocks = -1; return; }
        hipOccupancyMaxActiveBlocksPerMultiprocessor(&per_cu, (const void*)fwd_megakernel, NTHR, LDS_BYTES);
        if (per_cu < 1) per_cu = 1;
        grid_blocks = cus * per_cu;
        (void)hipGetLastError();
    }
    if (grid_blocks < 0) return;
    Args a{};
    for (int i = 0; i < 33; ++i) a.in[i] = (const float*)d_in[i];
    a.out = (float*)d_out; a.ws = (unsigned char*)d_ws;
    void* args[] = {&a};
    hipError_t e = hipLaunchCooperativeKernel((const void*)fwd_megakernel, dim3(grid_blocks), dim3(NTHR), args, LDS_BYTES, stream);
    if (e != hipSuccess) fprintf(stderr, "cooperative launch failed: %s (grid %d)\n", hipGetErrorString(e), grid_blocks);
}
```

```cpp
#include <hip/hip_runtime.h>
#include <hip/hip_bf16.h>
#include <hip/hip_cooperative_groups.h>
#include <cstdio>
#include <cstdint>
namespace cg = cooperative_groups;

#define LAS __attribute__((address_space(3)))
typedef unsigned short bf16_t;
typedef short bf16x8 __attribute__((ext_vector_type(8)));
typedef short s16x4 __attribute__((ext_vector_type(4)));
typedef float f32x4 __attribute__((ext_vector_type(4)));
typedef float f32x2 __attribute__((ext_vector_type(2)));
typedef float f32x16 __attribute__((ext_vector_type(16)));
typedef unsigned u32x4 __attribute__((ext_vector_type(4)));
typedef unsigned u32x2 __attribute__((ext_vector_type(2)));

constexpr int DM = 2048, DFF = 8192, NTOK = 16384, NCTXR = 8192;
constexpr int INW = 3520, INWP = 3584, KVROWS = 20480;
constexpr float EPSN = 1e-6f;
constexpr int ZU = 0, ZQB = 512, ZKB = 1280, ZVB = 1536, ZQC = 1792, ZCKV = 2944, ZKR = 3456;
constexpr size_t O_K = 33554432, O_V = 37748736, O_CKV = 41943040, O_KRO = 50331648, O_SSM = 51380224;
constexpr size_t MiB = 1u << 20;
constexpr size_t WS_XB = 902144;
constexpr size_t WS_CEN = 901120;
constexpr size_t WS_MOD = 0;
constexpr size_t WS_W = 1 * MiB;
constexpr size_t WL_IN = 0, WL_OUT = 14 * MiB, WL_FF1 = 22 * MiB, WL_FF2 = 54 * MiB, WL_GLU = 86 * MiB, WL_UKV = 87 * MiB, WL_SIZE = 89 * MiB;
constexpr size_t WS_HN = WS_W + 2 * WL_SIZE;
constexpr size_t WS_Z = WS_HN + 64 * MiB;
constexpr size_t WS_QB = WS_Z + 112 * MiB;
constexpr size_t WS_KB = WS_QB + 24 * MiB;
constexpr size_t WS_VB = WS_KB + 10 * MiB;
constexpr size_t WS_QC = WS_VB + 10 * MiB;
constexpr size_t WS_CKVN = WS_QC + 36 * MiB;
constexpr size_t WS_KR = WS_CKVN + 20 * MiB;
constexpr size_t WS_KVRAW = WS_KR + 5 * MiB;
constexpr size_t WS_KC = WS_KVRAW + 60 * MiB;
constexpr size_t WS_YF = WS_KC + 45 * MiB;
constexpr size_t WS_YB = WS_YF + 32 * MiB;
constexpr size_t WS_Y = WS_YB + 32 * MiB;
constexpr size_t WS_MIX = WS_Y + 16 * MiB;
constexpr size_t WS_END = WS_MIX + 64 * MiB;
constexpr size_t WS_HFF = WS_Z;
static_assert(WS_HFF + 256 * MiB <= WS_END, "hff overlay");
static_assert(WS_END <= 768 * MiB, "workspace");

struct Args {
    const float* in[33];
    float* out;
    unsigned char* ws;
};
typedef const __attribute__((address_space(4))) Args* AP;
#define RELOAD_ARGS() asm volatile("" : "+s"(a))

__device__ __forceinline__ unsigned f2bf(float f) { unsigned u = __builtin_bit_cast(unsigned, f); return (u + 0x7fffu + ((u >> 16) & 1u)) >> 16; }
__device__ __forceinline__ unsigned pk2(float lo, float hi) { unsigned r; asm("v_cvt_pk_bf16_f32 %0, %1, %2" : "=v"(r) : "v"(lo), "v"(hi)); return r; }
__device__ __forceinline__ float bf2f(unsigned short h) { return __builtin_bit_cast(float, (unsigned)h << 16); }
__device__ __forceinline__ float dpp_f(float v, const int ctrl_sel) {
    const int x = __builtin_bit_cast(int, v); int r;
    if (ctrl_sel == 0) r = __builtin_amdgcn_mov_dpp(x, 0xB1, 0xF, 0xF, true);
    else if (ctrl_sel == 1) r = __builtin_amdgcn_mov_dpp(x, 0x4E, 0xF, 0xF, true);
    else if (ctrl_sel == 2) r = __builtin_amdgcn_mov_dpp(x, 0x141, 0xF, 0xF, true);
    else r = __builtin_amdgcn_mov_dpp(x, 0x140, 0xF, 0xF, true);
    return __builtin_bit_cast(float, r);
}
__device__ __forceinline__ float wave_sum(float v) {
    v += dpp_f(v, 0); v += dpp_f(v, 1); v += dpp_f(v, 2); v += dpp_f(v, 3);
    v += __builtin_bit_cast(float, __builtin_amdgcn_ds_swizzle(__builtin_bit_cast(int, v), 0x401F));
    { auto rr = __builtin_amdgcn_permlane32_swap(__float_as_uint(v), __float_as_uint(v), false, false); v = __uint_as_float(rr[0]) + __uint_as_float(rr[1]); }
    return v;
}

namespace pg8 {
#define PG8_LAS __attribute__((address_space(3)))
constexpr int BM = 256, BK = 64, HALF = 128, HTB = HALF * BK * 2, STAGE_BYTES = 8 * HTB, NXCD = 8, WGM = 8;

__host__ __device__ __forceinline__ int lds_byte(int r, int c) { const int st = (r >> 4) * 2 + (c >> 5), rr = r & 15, cc = c & 31, ob = rr * 64 + cc * 2; return st * 1024 + (ob ^ (((ob >> 9) & 1) << 5)); }
__host__ __device__ __forceinline__ void stage_rc(int b, int& R, int& C) { const int st = b / 1024, sb = b % 1024, swz = sb ^ (((sb >> 9) & 1) << 5); R = (st >> 1) * 16 + swz / 64; C = (st & 1) * 32 + (swz % 64) / 2; }
__host__ __device__ __forceinline__ int perm32(int rho) { const int n = rho >> 4, i = rho & 15; return 8 * (i >> 2) + 4 * n + (i & 3); }

struct Unit { int pm, pn; };
struct Gemm { const bf16_t* A; const bf16_t* Bt; int M, N, K; };

struct StaticOrder {
    int nM, nN, nwg, start, end, xn, xr;
    __host__ __device__ void init(int M, int N, int G, int xp, int xn_, int xr_) { nM = M / BM; nN = N / BM; nwg = nM * nN; xn = xn_; xr = xr_;
        start = (int)((long)nwg * xp / G); end = (int)((long)nwg * (xp + xn_) / G); }
    __host__ __device__ bool next(int i, Unit& u) const {
        const int wgid = start + i * xn + xr; if (wgid >= end) return false;
        const int nig = WGM * nN, gid = wgid / nig, fm = gid * WGM, gsz = (nM - fm) < WGM ? (nM - fm) : WGM;
        u.pm = fm + ((wgid % nig) % gsz); u.pn = (wgid % nig) / gsz; return true;
    }
    __device__ __forceinline__ void a_ready(const Unit&) const {}
    __device__ __forceinline__ void done(const Unit&) const {}
};

template <int ACT  > struct EpiBf16 {
    static constexpr bool PERM = true, AFTER_DRAIN = false;
    bf16_t* O; int ldc;
    __device__ __forceinline__ void operator()(const f32x4 (&acc)[2][2][4][2], const Unit& u, int wr, int wc, int fr, int fq) const {
        const int row0 = u.pm * BM + wr * 64 + fr; const int col0 = u.pn * BM + wc * 32 + 8 * fq;
#pragma unroll
        for (int ai = 0; ai < 2; ++ai)
#pragma unroll
            for (int m = 0; m < 4; ++m) { bf16_t* rowp = O + (size_t)(row0 + ai * HALF + m * 16) * ldc + col0;
#pragma unroll
                for (int bj = 0; bj < 2; ++bj) { f32x4 v0 = acc[ai][bj][m][0], v1 = acc[ai][bj][m][1];
                    if (ACT == 2) {
#pragma unroll
                        for (int j = 0; j < 4; ++j) { float a = fmaxf(v0[j], 0.f), b = fmaxf(v1[j], 0.f); v0[j] = a * a; v1[j] = b * b; } }
                    u32x4 w; w.x = pk2(v0[0], v0[1]); w.y = pk2(v0[2], v0[3]); w.z = pk2(v1[0], v1[1]); w.w = pk2(v1[2], v1[3]);
                    *(u32x4*)(rowp + bj * HALF) = w; } }
    }
};
struct EpiGlu {
    static constexpr bool PERM = true, AFTER_DRAIN = false;
    bf16_t* O; int ldc;
    __device__ __forceinline__ void operator()(const f32x4 (&acc)[2][2][4][2], const Unit& u, int wr, int wc, int fr, int fq) const {
        const int row0 = u.pm * BM + wr * 64 + fr; const int col0 = u.pn * HALF + wc * 32 + 8 * fq;
#pragma unroll
        for (int ai = 0; ai < 2; ++ai)
#pragma unroll
            for (int m = 0; m < 4; ++m) { bf16_t* rowp = O + (size_t)(row0 + ai * HALF + m * 16) * ldc + col0;
                float o[8];
#pragma unroll
                for (int n = 0; n < 2; ++n)
#pragma unroll
                    for (int j = 0; j < 4; ++j) { const float a = acc[ai][0][m][n][j], g = acc[ai][1][m][n][j]; o[n * 4 + j] = a / (1.f + __expf(-g)); }
                u32x4 w; w.x = pk2(o[0], o[1]); w.y = pk2(o[2], o[3]); w.z = pk2(o[4], o[5]); w.w = pk2(o[6], o[7]);
                *(u32x4*)rowp = w; }
    }
};
struct EpiResGate {
    static constexpr bool PERM = false, AFTER_DRAIN = false;
    const float* xin0; const float* xin1; float* out; const float* gate;
    __device__ __forceinline__ void operator()(const f32x4 (&acc)[2][2][4][2], const Unit& u, int wr, int wc, int fr, int fq) const {
        const int rowt = u.pm * BM; const int set = rowt < NCTXR ? 0 : 1 + ((rowt - NCTXR) >> 10);
        const float* gp = gate + (size_t)set * 12288 + u.pn * BM + wc * 32 + 4 * fq;
        const float* xb = rowt < NCTXR ? xin0 + (size_t)rowt * DM : xin1 + (size_t)(rowt - NCTXR) * DM;
        f32x4 gv[2][2];
#pragma unroll
        for (int bj = 0; bj < 2; ++bj)
#pragma unroll
            for (int n = 0; n < 2; ++n) gv[bj][n] = *(const f32x4*)(gp + bj * HALF + n * 16);
#pragma unroll
        for (int ai = 0; ai < 2; ++ai)
#pragma unroll
            for (int m = 0; m < 4; ++m) { const int rl = ai * HALF + wr * 64 + m * 16 + fr; const size_t off = (size_t)rl * DM + u.pn * BM + wc * 32 + 4 * fq;
#pragma unroll
                for (int bj = 0; bj < 2; ++bj)
#pragma unroll
                    for (int n = 0; n < 2; ++n) { const f32x4 xv = *(const f32x4*)(xb + off + bj * HALF + n * 16);
                        *(f32x4*)(out + (size_t)rowt * DM + off + bj * HALF + n * 16) = xv + gv[bj][n] * acc[ai][bj][m][n]; } }
    }
};

template <class Epi, class Sched, bool ALIGN_EPI = false, bool SP2 = false>
__device__ __forceinline__ void gemm_phase(PG8_LAS unsigned char* lds, const Gemm g, const Sched& S, const Epi& E, const int tid) {
    const int wid = __builtin_amdgcn_readfirstlane(tid >> 6), lane = tid & 63, wr = wid >> 2, wc = wid & 3, fr = lane & 15, fq = lane >> 4;
    const int K = g.K, nt = K / BK;
    unsigned voffA[2], voffB[2];
#pragma unroll
    for (int i = 0; i < 2; ++i) { int R, C; stage_rc(tid * 16 + i * 8192, R, C); const int Rb = Epi::PERM ? ((R & ~31) + perm32(R & 31)) : R;
        voffA[i] = (unsigned)(R * K + C) * 2u; voffB[i] = (unsigned)(Rb * K + C) * 2u; }
    const size_t kstep = (size_t)(BK * 2);
    const size_t hstep = (size_t)HALF * K * 2;
    const size_t tstep = 2 * hstep;
    const unsigned ldsw = (unsigned)wid * 1024u;
    const int aoff = lds_byte(wr * 64 + fr, fq * 8), boff = lds_byte(wc * 32 + fr, fq * 8);
#define PG8_SA(b, h) (((b) * 2 + (h)) * HTB)
#define PG8_SB(b, h) ((4 + (b) * 2 + (h)) * HTB)
#define PG8_STAGE(bufoff, gbase, voff) do { _Pragma("unroll") for (int _i = 0; _i < 2; ++_i) \
        __builtin_amdgcn_global_load_lds((const unsigned*)((const char*)(gbase) + (voff)[_i]), (PG8_LAS unsigned*)(lds + (bufoff) + ldsw + _i * 8192), 16, 0, 0); } while (0)
#define PG8_LDA(dst, b, h) do { _Pragma("unroll") for (int m = 0; m < 4; ++m) _Pragma("unroll") for (int k = 0; k < 2; ++k) dst[m][k] = *(const PG8_LAS bf16x8*)(lds + PG8_SA(b, h) + aoff + m * 2048 + k * 1024); } while (0)
#define PG8_LDB(dst, b, h) do { _Pragma("unroll") for (int n = 0; n < 2; ++n) _Pragma("unroll") for (int k = 0; k < 2; ++k) dst[n][k] = *(const PG8_LAS bf16x8*)(lds + PG8_SB(b, h) + boff + n * 2048 + k * 1024); } while (0)
#define PG8_MMA(ai, bj, At, Bt) do { __builtin_amdgcn_s_setprio(1); _Pragma("unroll") for (int m = 0; m < 4; ++m) _Pragma("unroll") for (int n = 0; n < 2; ++n) _Pragma("unroll") for (int k = 0; k < 2; ++k) \
        acc[ai][bj][m][n] = __builtin_amdgcn_mfma_f32_16x16x32_bf16(Bt[n][k], At[m][k], acc[ai][bj][m][n], 0, 0, 0); __builtin_amdgcn_s_setprio(0); } while (0)
#define PG8_WAIT_V(n) asm volatile("s_waitcnt vmcnt(" #n ")" ::: "memory")
#define PG8_WAIT_L(n) asm volatile("s_waitcnt lgkmcnt(" #n ")" ::: "memory")
#define PG8_BAR __builtin_amdgcn_s_barrier()
#define PG8_SCHED __builtin_amdgcn_sched_barrier(0)
    Unit cur, nxt; int ui = 0;
    if (!S.next(0, cur)) return;
    f32x4 acc[2][2][4][2];
#pragma unroll
    for (int a = 0; a < 2; ++a)
#pragma unroll
        for (int b = 0; b < 2; ++b)
#pragma unroll
            for (int m = 0; m < 4; ++m)
#pragma unroll
                for (int n = 0; n < 2; ++n) acc[a][b][m][n] = (f32x4){0.f, 0.f, 0.f, 0.f};
    bf16x8 At[4][2], B0[2][2], B1[2][2];
    const char* cA = (const char*)g.A + (size_t)cur.pm * tstep; const char* cB = (const char*)g.Bt + (size_t)cur.pn * tstep;
    S.a_ready(cur);
    if constexpr (SP2) {
        PG8_STAGE(PG8_SB(0, 0), cB, voffB); PG8_STAGE(PG8_SB(0, 1), cB + hstep, voffB); PG8_STAGE(PG8_SA(0, 0), cA, voffA); PG8_STAGE(PG8_SA(0, 1), cA + hstep, voffA);
        if (wr == 1) PG8_BAR;
        PG8_WAIT_V(2); PG8_BAR;
        PG8_STAGE(PG8_SB(1, 0), cB + kstep, voffB); PG8_STAGE(PG8_SA(1, 0), cA + kstep, voffA); PG8_STAGE(PG8_SB(1, 1), cB + hstep + kstep, voffB);
        PG8_WAIT_V(6); PG8_BAR;
    } else {
        PG8_STAGE(PG8_SB(0, 0), cB, voffB); PG8_STAGE(PG8_SA(0, 0), cA, voffA); PG8_STAGE(PG8_SB(0, 1), cB + hstep, voffB); PG8_STAGE(PG8_SA(0, 1), cA + hstep, voffA);
        if (wr == 1) PG8_BAR;
        PG8_WAIT_V(4); PG8_BAR;
        PG8_STAGE(PG8_SB(1, 0), cB + kstep, voffB); PG8_STAGE(PG8_SA(1, 0), cA + kstep, voffA); PG8_STAGE(PG8_SB(1, 1), cB + hstep + kstep, voffB);
        PG8_WAIT_V(6); PG8_BAR;
    }
    for (;;) {
        const bool has_next = S.next(ui + 1, nxt);
        const char* nA = has_next ? (const char*)g.A + (size_t)nxt.pm * tstep : cA; const char* nB = has_next ? (const char*)g.Bt + (size_t)nxt.pn * tstep : cB;
        for (int t = 0; t < nt; t += 2) {
            const bool last = (t == nt - 2);
            const char* a1 = cA + (size_t)(t + 1) * kstep;
            const char* a2 = last ? nA : cA + (size_t)(t + 2) * kstep; const char* b2 = last ? nB : cB + (size_t)(t + 2) * kstep;
            const char* a3 = a2 + kstep; const char* b3 = b2 + kstep;
            if (last && has_next) S.a_ready(nxt);
            if constexpr (SP2) {
            PG8_LDB(B0, 0, 0); PG8_LDB(B1, 0, 1); PG8_SCHED; PG8_LDA(At, 0, 0); PG8_STAGE(PG8_SA(1, 1), a1 + hstep, voffA);
            PG8_WAIT_V(8); PG8_WAIT_L(0); PG8_BAR; PG8_MMA(0, 0, At, B0); PG8_MMA(0, 1, At, B1); PG8_BAR; PG8_SCHED;
            PG8_LDA(At, 0, 1); PG8_STAGE(PG8_SB(0, 0), b2, voffB); PG8_STAGE(PG8_SB(0, 1), b2 + hstep, voffB); PG8_STAGE(PG8_SA(0, 0), a2, voffA);
            PG8_WAIT_V(8); PG8_WAIT_L(0); PG8_BAR; PG8_MMA(1, 0, At, B0); PG8_MMA(1, 1, At, B1); PG8_BAR; PG8_SCHED;
            PG8_LDB(B0, 1, 0); PG8_LDB(B1, 1, 1); PG8_SCHED; PG8_LDA(At, 1, 0); PG8_STAGE(PG8_SA(0, 1), a2 + hstep, voffA);
            PG8_WAIT_V(8); PG8_WAIT_L(0); PG8_BAR; PG8_MMA(0, 0, At, B0); PG8_MMA(0, 1, At, B1); PG8_BAR; PG8_SCHED;
            PG8_LDA(At, 1, 1); PG8_STAGE(PG8_SB(1, 0), b3, voffB); PG8_STAGE(PG8_SB(1, 1), b3 + hstep, voffB); PG8_STAGE(PG8_SA(1, 0), a3, voffA);
            PG8_WAIT_V(8); PG8_WAIT_L(0); PG8_BAR; PG8_MMA(1, 0, At, B0); PG8_MMA(1, 1, At, B1); PG8_BAR; PG8_SCHED;
            } else {
            PG8_LDB(B0, 0, 0); PG8_SCHED; PG8_LDA(At, 0, 0); PG8_STAGE(PG8_SA(1, 1), a1 + hstep, voffA);
            PG8_WAIT_L(8); PG8_BAR; PG8_WAIT_L(0); PG8_MMA(0, 0, At, B0); PG8_BAR; PG8_SCHED;
            PG8_LDB(B1, 0, 1); PG8_STAGE(PG8_SB(0, 0), b2, voffB);
            PG8_BAR; PG8_WAIT_L(0); PG8_MMA(0, 1, At, B1); PG8_BAR;
            PG8_LDA(At, 0, 1); PG8_STAGE(PG8_SA(0, 0), a2, voffA);
            PG8_BAR; PG8_WAIT_L(0); PG8_MMA(1, 0, At, B0); PG8_BAR; PG8_SCHED;
            PG8_STAGE(PG8_SB(0, 1), b2 + hstep, voffB);
            PG8_WAIT_V(6); PG8_BAR; PG8_MMA(1, 1, At, B1); PG8_BAR;
            PG8_LDB(B0, 1, 0); PG8_SCHED; PG8_LDA(At, 1, 0); PG8_STAGE(PG8_SA(0, 1), a2 + hstep, voffA);
            PG8_WAIT_L(8); PG8_BAR; PG8_WAIT_L(0); PG8_MMA(0, 0, At, B0); PG8_BAR; PG8_SCHED;
            PG8_LDB(B1, 1, 1); PG8_STAGE(PG8_SB(1, 0), b3, voffB);
            PG8_BAR; PG8_WAIT_L(0); PG8_MMA(0, 1, At, B1); PG8_BAR;
            PG8_LDA(At, 1, 1); PG8_STAGE(PG8_SA(1, 0), a3, voffA);
            PG8_BAR; PG8_WAIT_L(0); PG8_MMA(1, 0, At, B0); PG8_BAR; PG8_SCHED;
            PG8_STAGE(PG8_SB(1, 1), b3 + hstep, voffB);
            PG8_WAIT_V(6); PG8_BAR; PG8_MMA(1, 1, At, B1); PG8_BAR;
            }
        }
        if constexpr (ALIGN_EPI) { if (wr == 0) PG8_BAR; }
        if constexpr (!Epi::AFTER_DRAIN) { E(acc, cur, wr, wc, fr, fq); S.done(cur); }
        if (!has_next) break;
#pragma unroll
        for (int a = 0; a < 2; ++a)
#pragma unroll
            for (int b = 0; b < 2; ++b)
#pragma unroll
                for (int m = 0; m < 4; ++m)
#pragma unroll
                    for (int n = 0; n < 2; ++n) acc[a][b][m][n] = (f32x4){0.f, 0.f, 0.f, 0.f};
        cur = nxt; cA = nA; cB = nB; ++ui;
        if constexpr (ALIGN_EPI) { if (wr == 1) PG8_BAR; }
    }
    PG8_WAIT_V(0);
    if constexpr (!ALIGN_EPI) { if (wr == 0) PG8_BAR; }
    PG8_BAR;
#undef PG8_SA
#undef PG8_SB
#undef PG8_STAGE
#undef PG8_LDA
#undef PG8_LDB
#undef PG8_MMA
#undef PG8_WAIT_V
#undef PG8_WAIT_L
#undef PG8_BAR
#undef PG8_SCHED
}
}

namespace att {
constexpr int NW = 8, QBLK = 32, KVBLK = 64, LDO = 2048;
constexpr size_t SHM_V = KVBLK * 128 * 2, SHM_K = KVBLK * 128 * 2, SHM_KR = KVBLK * 64 * 2;
constexpr size_t OFF_K = 2 * SHM_V, OFF_KR = OFF_K + 2 * SHM_K, OFF_WS = OFF_KR + 2 * SHM_KR, OFF_QR = OFF_WS + NW * 64 * 4, SHM_ATTN = OFF_QR + NW * 4 * 64 * 16;
#define KSWZ(row, colB) ((row) * 256 + ((colB) ^ (((row) & 7) << 4)))
#define KRSWZ(row, colB) ((row) * 128 + ((colB) ^ (((row) & 7) << 4)))
#define SBAR() __builtin_amdgcn_sched_barrier(0)
__device__ __forceinline__ int crow(int r, int hi) { return (r & 3) + 8 * (r >> 2) + 4 * hi; }
__device__ __forceinline__ unsigned cvtpk(float lo, float hi) { unsigned r; asm volatile("v_cvt_pk_bf16_f32 %0, %1, %2" : "=v"(r) : "v"(lo), "v"(hi)); return r; }
constexpr float THR = 8.f;

template <int DQK> struct Sc { static constexpr float SCALE = DQK == 128 ? 0.088388347648318440f : 0.072168783648703220f; };

template <int DQK> __device__ __forceinline__ void partialSM(f32x16& p0, f32x16& p1, float& m_reg, float& mn, float& alpha) {
  constexpr float SCALE = Sc<DQK>::SCALE; constexpr float C = SCALE * 1.4426950408889634f;
  float pmax = p0[0];
#pragma unroll
  for (int r = 1; r < 16; ++r) pmax = fmaxf(pmax, p0[r]);
#pragma unroll
  for (int r = 0; r < 16; ++r) pmax = fmaxf(pmax, p1[r]);
  { auto rr = __builtin_amdgcn_permlane32_swap(__float_as_uint(pmax), __float_as_uint(pmax), false, false);
    pmax = fmaxf(__uint_as_float(rr[0]), __uint_as_float(rr[1])); }
  if (__builtin_expect(__all(pmax - m_reg <= THR / SCALE), 1)) { mn = m_reg; alpha = 1.f; }
  else { mn = fmaxf(m_reg, pmax); alpha = __builtin_amdgcn_exp2f((m_reg - mn) * C); m_reg = mn; }
  float mnC = -mn * C;
#pragma unroll
  for (int r = 0; r < 16; ++r) p0[r] = fmaf(p0[r], C, mnC);
#pragma unroll
  for (int r = 0; r < 16; ++r) p1[r] = fmaf(p1[r], C, mnC);
#pragma unroll
  for (int r = 0; r < 16; ++r) p0[r] = __builtin_amdgcn_exp2f(p0[r]);
}
__device__ __forceinline__ void finishSM(f32x16& p0, f32x16& p1, float alpha, float& l_reg, bf16x8& pa0, bf16x8& pa1, bf16x8& pa2, bf16x8& pa3) {
#pragma unroll
  for (int r = 0; r < 16; ++r) p1[r] = __builtin_amdgcn_exp2f(p1[r]);
  float ps = 0;
#pragma unroll
  for (int r = 0; r < 16; ++r) ps += p0[r];
#pragma unroll
  for (int r = 0; r < 16; ++r) ps += p1[r];
  { auto rr = __builtin_amdgcn_permlane32_swap(__float_as_uint(ps), __float_as_uint(ps), false, false);
    ps = __uint_as_float(rr[0]) + __uint_as_float(rr[1]); }
  l_reg = l_reg * alpha + ps;
#define PK4(P, BASE, OUT) do { unsigned a0 = cvtpk(P[BASE + 0], P[BASE + 1]), a1 = cvtpk(P[BASE + 2], P[BASE + 3]);   \
    unsigned b0 = cvtpk(P[BASE + 4], P[BASE + 5]), b1 = cvtpk(P[BASE + 6], P[BASE + 7]);                              \
    auto r0 = __builtin_amdgcn_permlane32_swap(a0, b0, false, false); auto r1 = __builtin_amdgcn_permlane32_swap(a1, b1, false, false); \
    u32x4 w = {r0[0], r1[0], r0[1], r1[1]}; OUT = *reinterpret_cast<bf16x8*>(&w); } while (0)
  PK4(p0, 0, pa0); PK4(p0, 8, pa1); PK4(p1, 0, pa2); PK4(p1, 8, pa3);
#undef PK4
}
template <int DQK> __device__ __forceinline__ void qkt(f32x16& p0, f32x16& p1, const char* Ks, const char* Krs, const bf16x8* qr, const char* qrl, int r32, int hi) {
  p0 = f32x16{}; p1 = f32x16{};
#pragma unroll
  for (int d0 = 0; d0 < 8; ++d0) { int cb = (d0 * 16 + hi * 8) * 2;
    bf16x8 b0 = *reinterpret_cast<const bf16x8*>(Ks + KSWZ(r32, cb));
    bf16x8 b1 = *reinterpret_cast<const bf16x8*>(Ks + KSWZ(32 + r32, cb));
    p0 = __builtin_amdgcn_mfma_f32_32x32x16_bf16(b0, qr[d0], p0, 0, 0, 0);
    p1 = __builtin_amdgcn_mfma_f32_32x32x16_bf16(b1, qr[d0], p1, 0, 0, 0); }
  if constexpr (DQK == 192) {
#pragma unroll
    for (int d0 = 0; d0 < 4; ++d0) { int cb = (d0 * 16 + hi * 8) * 2;
      bf16x8 b0 = *reinterpret_cast<const bf16x8*>(Krs + KRSWZ(r32, cb));
      bf16x8 b1 = *reinterpret_cast<const bf16x8*>(Krs + KRSWZ(32 + r32, cb));
      const bf16x8 qf = *reinterpret_cast<const bf16x8*>(qrl + d0 * 1024);
      p0 = __builtin_amdgcn_mfma_f32_32x32x16_bf16(b0, qf, p0, 0, 0, 0);
      p1 = __builtin_amdgcn_mfma_f32_32x32x16_bf16(b1, qf, p1, 0, 0, 0); }
  }
}
__device__ __forceinline__ int v_st(int k, int c) { const int kk = (k & ~0xC) | ((k & 4) << 1) | ((k & 8) >> 1); return ((kk >> 3) * 4 + (c >> 5)) * 512 + ((kk & 7) * 32 + (c & 31)) * 2; }
__device__ __forceinline__ int v_rd_base(int lane) { return ((lane & 3) << 3) | (((lane >> 2) & 3) << 6) | (((lane >> 4) & 1) << 5) | (((lane >> 5) & 1) << 8); }
constexpr int v_rd_off(int d0, int ks, int half) { return d0 * 512 + ks * 4096 + half * 2048; }
template <int OFF> __device__ __forceinline__ s16x4 tr_read(int vb) {
  s16x4 r; asm volatile("ds_read_b64_tr_b16 %0, %1 offset:%2" : "=&v"(r) : "v"(vb), "i"(OFF) : "memory"); return r;
}
template <int D0> __device__ __forceinline__ void pv_one(f32x16& od, int vb, bf16x8 pa0, bf16x8 pa1, bf16x8 pa2, bf16x8 pa3) {
  const s16x4 l0 = tr_read<v_rd_off(D0, 0, 0)>(vb), h0 = tr_read<v_rd_off(D0, 0, 1)>(vb), l1 = tr_read<v_rd_off(D0, 1, 0)>(vb), h1 = tr_read<v_rd_off(D0, 1, 1)>(vb);
  const s16x4 l2 = tr_read<v_rd_off(D0, 2, 0)>(vb), h2 = tr_read<v_rd_off(D0, 2, 1)>(vb), l3 = tr_read<v_rd_off(D0, 3, 0)>(vb), h3 = tr_read<v_rd_off(D0, 3, 1)>(vb);
  asm volatile("s_waitcnt lgkmcnt(0)" ::: "memory"); SBAR();
#define PK(L, H) (bf16x8){L[0], L[1], L[2], L[3], H[0], H[1], H[2], H[3]}
  od = __builtin_amdgcn_mfma_f32_32x32x16_bf16(pa0, PK(l0, h0), od, 0, 0, 0);
  od = __builtin_amdgcn_mfma_f32_32x32x16_bf16(pa1, PK(l1, h1), od, 0, 0, 0);
  od = __builtin_amdgcn_mfma_f32_32x32x16_bf16(pa2, PK(l2, h2), od, 0, 0, 0);
  od = __builtin_amdgcn_mfma_f32_32x32x16_bf16(pa3, PK(l3, h3), od, 0, 0, 0);
#undef PK
}
__device__ __forceinline__ void pv_d0(f32x16* o, int vb, bf16x8 pa0, bf16x8 pa1, bf16x8 pa2, bf16x8 pa3) {
  pv_one<0>(o[0], vb, pa0, pa1, pa2, pa3); pv_one<1>(o[1], vb, pa0, pa1, pa2, pa3); pv_one<2>(o[2], vb, pa0, pa1, pa2, pa3); pv_one<3>(o[3], vb, pa0, pa1, pa2, pa3);
}

template <int DQK, int LDQ, int LDK, int LDV>
__device__ __forceinline__ void attn_body(const bf16_t* __restrict__ Qb, const bf16_t* __restrict__ Kh, const bf16_t* __restrict__ Vh,
                                          bf16_t* __restrict__ Ob, int seq, char* lds, const int tid) {
  constexpr int NQ = 8; constexpr int SD = DQK == 192 ? 1 : 2;
  const int wid = tid >> 6, lane = tid & 63, r32 = lane & 31, hi = lane >> 5;
  char* V_lds = lds; char* K_lds = lds + OFF_K; char* KR_lds = lds + OFF_KR;
  float* ws = (float*)(lds + OFF_WS) + wid * 64; float* li_l = ws; float* al_l = ws + 32;
  float m_reg = -1e30f, l_reg = 0; f32x16 o[4] = {}; bf16x8 qr[NQ];
  const bf16_t* Qw = Qb + (long)(wid * QBLK + r32) * LDQ + hi * 8;
#pragma unroll
  for (int d0 = 0; d0 < NQ; ++d0) qr[d0] = *reinterpret_cast<const bf16x8*>(Qw + d0 * 16);
  char* qrl = lds + OFF_QR + wid * 4096 + lane * 16;
  if constexpr (DQK == 192) {
#pragma unroll
    for (int d0 = 0; d0 < 4; ++d0) *reinterpret_cast<bf16x8*>(qrl + d0 * 1024) = *reinterpret_cast<const bf16x8*>(Qw + 128 + d0 * 16);
  }
  const int sr = tid >> 4, sc = (tid & 15) * 8, vst0 = v_st(sr, sc), vst1 = v_st(32 + sr, sc);
  const int rr_ = tid >> 3, rc_ = (tid & 7) * 8;
  const int vb0 = (int)(uintptr_t)V_lds + v_rd_base(lane);
  struct { bf16x8 vs0, vs1, ks0, ks1, kr; } sr_[SD];
  const unsigned voffV = (unsigned)(sr * LDV + sc) * 2u, voffK = (unsigned)(sr * LDK + sc) * 2u, voffR = (unsigned)(rr_ * LDK + 128 + rc_) * 2u;
#define SLOAD(i, k0) do { const char* vb_ = (const char*)(Vh + (size_t)(k0) * LDV); const char* kb_ = (const char*)(Kh + (size_t)(k0) * LDK); \
    sr_[i].vs0 = *(const bf16x8*)(vb_ + voffV); sr_[i].vs1 = *(const bf16x8*)(vb_ + 32 * LDV * 2 + voffV); \
    sr_[i].ks0 = *(const bf16x8*)(kb_ + voffK); sr_[i].ks1 = *(const bf16x8*)(kb_ + 32 * LDK * 2 + voffK); \
    if constexpr (DQK == 192) sr_[i].kr = *(const bf16x8*)(kb_ + voffR); } while (0)
#define SWRITE(b, i) do { *(bf16x8*)(V_lds + (b) * SHM_V + vst0) = sr_[i].vs0;          \
    *(bf16x8*)(V_lds + (b) * SHM_V + vst1) = sr_[i].vs1; int kc = sc * 2;               \
    *(bf16x8*)(K_lds + (b) * SHM_K + KSWZ(sr, kc)) = sr_[i].ks0;                       \
    *(bf16x8*)(K_lds + (b) * SHM_K + KSWZ(32 + sr, kc)) = sr_[i].ks1;                  \
    if constexpr (DQK == 192) *(bf16x8*)(KR_lds + (b) * SHM_KR + KRSWZ(rr_, rc_ * 2)) = sr_[i].kr; } while (0)
#define SWAIT() do { if constexpr (SD == 1) asm volatile("s_waitcnt vmcnt(0)" ::: "memory"); else asm volatile("s_waitcnt vmcnt(4)" ::: "memory"); } while (0)
#define RESC(a) do { if (__any((a) < 1.f)) { if (hi == 0) al_l[r32] = (a); asm volatile("s_waitcnt lgkmcnt(0)" ::: "memory"); \
    _Pragma("unroll") for (int d = 0; d < 4; ++d) _Pragma("unroll") for (int r = 0; r < 16; ++r) o[d][r] *= al_l[crow(r, hi)]; } } while (0)
  f32x16 pA0, pA1, pB0, pB1; float mnA, mnB, alA, alB; bf16x8 pa0, pa1, pa2, pa3; const int NT = seq / KVBLK;
  constexpr int SE = 0, SO = SD - 1;
  SLOAD(SE, 0); asm volatile("s_waitcnt vmcnt(0)" ::: "memory"); SWRITE(0, SE); __syncthreads();
  qkt<DQK>(pA0, pA1, K_lds, KR_lds, qr, qrl, r32, hi); partialSM<DQK>(pA0, pA1, m_reg, mnA, alA);
  SLOAD(SO, KVBLK); if constexpr (SD == 2) { if (2 < NT) SLOAD(SE, 2 * KVBLK); }
  SWAIT(); SWRITE(1, SO); __syncthreads();
  for (int j = 1; j + 1 < NT; j += 2) {
    SBAR(); qkt<DQK>(pB0, pB1, K_lds + SHM_K, KR_lds + SHM_KR, qr, qrl, r32, hi);
    finishSM(pA0, pA1, alA, l_reg, pa0, pa1, pa2, pa3); SBAR();
    SLOAD(SO, (j + SD) * KVBLK); SBAR();
    pv_d0(o, vb0, pa0, pa1, pa2, pa3); partialSM<DQK>(pB0, pB1, m_reg, mnB, alB);
    __syncthreads(); SWAIT(); SWRITE(0, SE);
    RESC(alB); __syncthreads();
    SBAR(); qkt<DQK>(pA0, pA1, K_lds, KR_lds, qr, qrl, r32, hi);
    finishSM(pB0, pB1, alB, l_reg, pa0, pa1, pa2, pa3); SBAR();
    if (SD == 1 || j + 3 < NT) SLOAD(SE, (j + 1 + SD) * KVBLK); SBAR();
    pv_d0(o, vb0 + (int)SHM_V, pa0, pa1, pa2, pa3); partialSM<DQK>(pA0, pA1, m_reg, mnA, alA);
    __syncthreads(); SWAIT(); SWRITE(1, SO);
    RESC(alA); __syncthreads();
  }
  SBAR(); qkt<DQK>(pB0, pB1, K_lds + SHM_K, KR_lds + SHM_KR, qr, qrl, r32, hi);
  finishSM(pA0, pA1, alA, l_reg, pa0, pa1, pa2, pa3); SBAR();
  pv_d0(o, vb0, pa0, pa1, pa2, pa3); partialSM<DQK>(pB0, pB1, m_reg, mnB, alB);
  __syncthreads(); RESC(alB);
  finishSM(pB0, pB1, alB, l_reg, pa0, pa1, pa2, pa3); SBAR();
  pv_d0(o, vb0 + (int)SHM_V, pa0, pa1, pa2, pa3);
  LAS unsigned char* ldsl = (LAS unsigned char*)lds;
  LAS float* li3 = (LAS float*)(ldsl + OFF_WS) + wid * 64;
  if (hi == 0) li3[r32] = l_reg; asm volatile("s_waitcnt lgkmcnt(0)" ::: "memory");
  float rli[16];
#pragma unroll
  for (int r = 0; r < 16; ++r) rli[r] = __builtin_amdgcn_rcpf(li3[crow(r, hi)]);
  __syncthreads();
  { LAS bf16_t* stg = (LAS bf16_t*)(ldsl + wid * 8192);
#pragma unroll
    for (int r = 0; r < 16; ++r) { const int orow = crow(r, hi);
#pragma unroll
      for (int d0 = 0; d0 < 4; ++d0) stg[orow * 128 + d0 * 32 + r32] = (bf16_t)f2bf(o[d0][r] * rli[r]); }
    asm volatile("s_waitcnt lgkmcnt(0)" ::: "memory");
    bf16_t* Obl = Ob; asm volatile("" : "+s"(Obl));
    int lane_l = lane; asm volatile("" : "+v"(lane_l));
    bf16_t* Ow = Obl + (long)(wid * QBLK + (lane_l >> 4)) * LDO + (lane_l & 15) * 8;
    const LAS bf16_t* sp = stg + (lane_l >> 4) * 128 + (lane_l & 15) * 8;
#pragma unroll 1
    for (int i = 0; i < 8; ++i) { const u32x4 v = *(const LAS u32x4*)(sp + i * 512); *(u32x4*)Ow = v; Ow += 4 * LDO; } }
  __syncthreads();
#undef SLOAD
#undef SWRITE
#undef SWAIT
#undef RESC
}
}

constexpr int NWAVES = 8, NTHR = 512;
constexpr int LDS_BYTES = 131072 + 1024;

struct Ctx {
    int tid, lane, wave, G, gw, NGW, bx;
    int xp, xn, xr, vc;
};

__device__ __forceinline__ void p0_transpose_item(const float* W, int K, int N, bf16_t* WT, int k0, int n0, int drow0, LAS float* scr, int lane) {
#pragma unroll 8
    for (int i = 0; i < 32; ++i) { const int kk = 2 * i + (lane >> 5); scr[kk * 33 + (lane & 31)] = W[(size_t)(k0 + kk) * N + n0 + (lane & 31)]; }
    asm volatile("s_waitcnt lgkmcnt(0)" ::: "memory");
    const int c = lane & 7;
#pragma unroll
    for (int j = 0; j < 4; ++j) { const int n = (lane >> 3) + 8 * j; const LAS float* s = scr + (8 * c) * 33 + n;
        u32x4 o; o.x = pk2(s[0 * 33], s[1 * 33]); o.y = pk2(s[2 * 33], s[3 * 33]); o.z = pk2(s[4 * 33], s[5 * 33]); o.w = pk2(s[6 * 33], s[7 * 33]);
        *(u32x4*)(WT + (size_t)(drow0 + n) * K + k0 + 8 * c) = o; }
    asm volatile("s_waitcnt lgkmcnt(0)" ::: "memory");
}

__device__ __forceinline__ void phase0(AP a, const Ctx& c, LAS unsigned char* lds) {
    LAS float* sil = (LAS float*)lds;
    for (int i = c.tid; i < 9 * 2048; i += NTHR) { const int s = i >> 11, k = i & 2047; const float v = s == 0 ? a->in[8][k] : a->in[7][(s - 1) * 2048 + k]; sil[i] = v / (1.f + __expf(-v)); }
    __syncthreads();
    float* mod = (float*)(a->ws + WS_MOD);
    LAS float* red = (LAS float*)(lds + 73728);
    for (int it = c.bx; it < 2 * 96; it += c.G) {
        const int l = it / 96, cb = it % 96; const int col = cb * 128 + c.lane * 2;
        const float* wp = a->in[9] + ((size_t)l * 2048 + c.wave * 256) * 12288 + col;
        f32x2 acc[9];
#pragma unroll
        for (int s = 0; s < 9; ++s) acc[s] = (f32x2){0.f, 0.f};
#pragma unroll 8
        for (int k = 0; k < 256; ++k) { const f32x2 w = *(const f32x2*)(wp + (size_t)k * 12288);
#pragma unroll
            for (int s = 0; s < 9; ++s) acc[s] += w * sil[s * 2048 + c.wave * 256 + k]; }
#pragma unroll
        for (int s = 0; s < 9; ++s) *(LAS f32x2*)(red + (c.wave * 9 + s) * 128 + c.lane * 2) = acc[s];
        __syncthreads();
        for (int idx = c.tid; idx < 9 * 128; idx += NTHR) { const int s = idx >> 7, cc = idx & 127; float v = a->in[10][(size_t)l * 12288 + cb * 128 + cc];
#pragma unroll
            for (int w = 0; w < 8; ++w) v += red[(w * 9 + s) * 128 + cc];
            mod[((size_t)l * 9 + s) * 12288 + cb * 128 + cc] = v; }
        __syncthreads();
    }
    __syncthreads();
    LAS float* scr = (LAS float*)(lds + c.wave * 8448);
    constexpr int I_IN = 32 * 110, I_OUT = 32 * 64, I_F1 = 32 * 256, I_F2 = 128 * 64, I_GLU = 8 * 32, I_UK = 8 * 24;
    constexpr int I_L = I_IN + I_OUT + I_F1 + I_F2 + I_GLU + 2 * I_UK;
    for (int it = c.gw; it < 2 * I_L; it += c.NGW) {
        const int l = it / I_L; int r = it % I_L;
        unsigned char* wl = a->ws + WS_W + (size_t)l * WL_SIZE;
        const float* W; int K, N; bf16_t* WT; int mode = 0, roff = 0;
        if (r < I_IN) { W = a->in[13] + (size_t)l * 2048 * INW; K = 2048; N = INW; WT = (bf16_t*)(wl + WL_IN); }
        else if ((r -= I_IN) < I_OUT) { W = a->in[30] + (size_t)l * 2048 * 2048; K = 2048; N = 2048; WT = (bf16_t*)(wl + WL_OUT); }
        else if ((r -= I_OUT) < I_F1) { W = a->in[31] + (size_t)l * 2048 * 8192; K = 2048; N = 8192; WT = (bf16_t*)(wl + WL_FF1); }
        else if ((r -= I_F1) < I_F2) { W = a->in[32] + (size_t)l * 8192 * 2048; K = 8192; N = 2048; WT = (bf16_t*)(wl + WL_FF2); }
        else if ((r -= I_F2) < I_GLU) { W = a->in[29] + (size_t)l * 512 * 1024; K = 512; N = 1024; WT = (bf16_t*)(wl + WL_GLU); mode = 1; }
        else if ((r -= I_GLU) < I_UK) { W = a->in[19] + (size_t)l * 512 * 768; K = 512; N = 768; WT = (bf16_t*)(wl + WL_UKV); }
        else { r -= I_UK; W = a->in[20] + (size_t)l * 512 * 768; K = 512; N = 768; WT = (bf16_t*)(wl + WL_UKV); roff = 768; }
        const int nblk = N / 32, kb = r / nblk, nb = r % nblk, k0 = 64 * kb, n0 = 32 * nb;
        int drow0 = n0 + roff;
        if (mode == 1) { drow0 = n0 < 512 ? 256 * (n0 >> 7) + (n0 & 127) : 256 * ((n0 - 512) >> 7) + 128 + ((n0 - 512) & 127); }
        p0_transpose_item(W, K, N, WT, k0, n0, drow0, scr, c.lane);
    }
    for (int i = c.gw * 64 + c.lane; i < 2 * 64 * 256; i += c.NGW * 64) { const int l = i / (64 * 256), q = i % (64 * 256);
        bf16_t* WT = (bf16_t*)(a->ws + WS_W + (size_t)l * WL_SIZE + WL_IN) + (size_t)INW * 2048;
        *(u32x4*)(WT + (size_t)q * 8) = (u32x4){0u, 0u, 0u, 0u}; }
}

__device__ __forceinline__ void phase_norm(AP a, const Ctx& c, int l, int which  , bool x_from_in) {
    const float* gw = a->in[which ? 12 : 11] + (size_t)l * DM;
    const float* modl = (const float*)(a->ws + WS_MOD) + (size_t)l * 9 * 12288;
    bf16_t* HN = (bf16_t*)(a->ws + WS_HN);
    auto xptr = [&](int r) { return x_from_in ? (r < NCTXR ? a->in[0] + (size_t)r * DM : a->in[1] + (size_t)(r - NCTXR) * DM) : a->out + (size_t)r * DM; };
    f32x4 vn[8];
    if (c.gw < NTOK) { const f32x4* xr = (const f32x4*)xptr(c.gw) + c.lane;
#pragma unroll
        for (int j = 0; j < 8; ++j) vn[j] = xr[64 * j]; }
    for (int r = c.gw; r < NTOK; r += c.NGW) {
        const int set = r < NCTXR ? 0 : 1 + ((r - NCTXR) >> 10);
        const float* shp = modl + (size_t)set * 12288 + (which ? 3 * DM : 0); const float* scp = shp + DM;
        f32x4 v[8]; float s = 0.f;
#pragma unroll
        for (int j = 0; j < 8; ++j) { v[j] = vn[j]; s += (v[j].x * v[j].x + v[j].y * v[j].y) + (v[j].z * v[j].z + v[j].w * v[j].w); }
        f32x4 gg[8], sc[8], sh[8];
#pragma unroll
        for (int j = 0; j < 8; ++j) { gg[j] = ((const f32x4*)gw)[c.lane + 64 * j]; sc[j] = ((const f32x4*)scp)[c.lane + 64 * j]; sh[j] = ((const f32x4*)shp)[c.lane + 64 * j]; }
        if (r + c.NGW < NTOK) { const f32x4* xr = (const f32x4*)xptr(r + c.NGW) + c.lane;
#pragma unroll
            for (int j = 0; j < 8; ++j) vn[j] = xr[64 * j]; }
        asm volatile("" ::: "memory");
        const float rstd = rsqrtf(wave_sum(s) * (1.f / DM) + EPSN);
        u32x2* o8 = (u32x2*)(HN + (size_t)r * DM) + c.lane;
#pragma unroll
        for (int j = 0; j < 8; ++j) { const f32x4 y = v[j] * rstd * gg[j] * (sc[j] + 1.f) + sh[j]; u32x2 w; w.x = pk2(y.x, y.y); w.y = pk2(y.z, y.w); o8[64 * j] = w; }
    }
}

constexpr float L2_10000 = 13.287712379549449f;
__device__ __forceinline__ float swz16(float v) { return __builtin_bit_cast(float, __builtin_amdgcn_ds_swizzle(__builtin_bit_cast(int, v), 0x401F)); }
__device__ __forceinline__ float swz8(float v) { return __builtin_bit_cast(float, __builtin_amdgcn_ds_swizzle(__builtin_bit_cast(int, v), 0x201F)); }
__device__ __forceinline__ float lo_bf(unsigned w) { return __builtin_bit_cast(float, w << 16); }
__device__ __forceinline__ float hi_bf(unsigned w) { return __builtin_bit_cast(float, w & 0xffff0000u); }
__device__ __forceinline__ float rowsum16(float v) { v += dpp_f(v, 0); v += dpp_f(v, 1); v += dpp_f(v, 2); v += dpp_f(v, 3); return v; }
__device__ __forceinline__ float rlf(float v, int lane_) { return __builtin_bit_cast(float, __builtin_amdgcn_readlane(__builtin_bit_cast(int, v), lane_)); }
__device__ __forceinline__ float ror8(float v) { return __builtin_bit_cast(float, __builtin_amdgcn_mov_dpp(__builtin_bit_cast(int, v), 0x128, 0xF, 0xF, true)); }
__device__ __forceinline__ float swz4(float v) { return __builtin_bit_cast(float, __builtin_amdgcn_ds_swizzle(__builtin_bit_cast(int, v), 0x101F)); }
__device__ __forceinline__ void zpost_rows(AP a, const Ctx& c, int l) {
    const bf16_t* Z = (const bf16_t*)(a->ws + WS_Z);
    bf16_t* QB = (bf16_t*)(a->ws + WS_QB); bf16_t* KB = (bf16_t*)(a->ws + WS_KB); bf16_t* VB = (bf16_t*)(a->ws + WS_VB);
    bf16_t* QC = (bf16_t*)(a->ws + WS_QC); bf16_t* CKVN = (bf16_t*)(a->ws + WS_CKVN); float* KR = (float*)(a->ws + WS_KR);
    const int lane = c.lane;
    const int hp = lane >> 5, m = lane & 31;
    const int halfg = m >> 4; const bool isx1 = (m & 8) == 0; const int ig = 4 * (m & 7);
    float invg[4], invc[4];
#pragma unroll
    for (int e = 0; e < 4; ++e) invg[e] = __builtin_amdgcn_exp2f(-(float)(ig + e) * (L2_10000 / 32.f));
    const f32x4 gq4 = *(const f32x4*)(a->in[14] + l * 128 + 4 * m), gk4 = *(const f32x4*)(a->in[15] + l * 128 + 4 * m);
    const int mt = lane & 15, ht = lane >> 4;
    const int halfc = mt >> 3; const bool isx1c = (mt & 4) == 0; const int ic = 4 * (mt & 3);
#pragma unroll
    for (int e = 0; e < 4; ++e) invc[e] = __builtin_amdgcn_exp2f(-(float)(ic + e) * (L2_10000 / 16.f));
    const f32x4 gcn4 = *(const f32x4*)(a->in[17] + l * 192 + 4 * m), gcr4 = *(const f32x4*)(a->in[17] + l * 192 + 128 + 4 * mt);
    const f32x4 gkv0 = *(const f32x4*)(a->in[16] + l * 512 + lane * 8), gkv1 = *(const f32x4*)(a->in[16] + l * 512 + lane * 8 + 4);
    const bool zsplit = c.G * NWAVES > 512 + 64;
    if (zsplit && c.wave < 2) return;
    const int zgw = zsplit ? c.bx * 6 + (c.wave - 2) : c.gw, zn = zsplit ? c.G * 6 : c.NGW;
    for (int r = zgw; r < NTOK + 4096; r += zn) {
        if (r >= NTOK) {
            const int q = r - NTOK, b = q >> 9, t = q & 511; const size_t kvrow = 8192 + (size_t)b * 1536 + t; const size_t crow_ = ((size_t)(b * 2 + l) * 512 + t);
            const f32x4 kk = *(const f32x4*)(a->in[2] + crow_ * 256 + lane * 4), vv = *(const f32x4*)(a->in[3] + crow_ * 256 + lane * 4);
            const f32x4 c0 = *(const f32x4*)(a->in[4] + crow_ * 512 + lane * 8), c1 = *(const f32x4*)(a->in[4] + crow_ * 512 + lane * 8 + 4);
            const float krv = a->in[5][crow_ * 64 + lane];
            u32x2 w; w.x = pk2(kk.x, kk.y); w.y = pk2(kk.z, kk.w); *(u32x2*)(KB + kvrow * 256 + lane * 4) = w;
            w.x = pk2(vv.x, vv.y); w.y = pk2(vv.z, vv.w); *(u32x2*)(VB + kvrow * 256 + lane * 4) = w;
            u32x4 w4; w4.x = pk2(c0.x, c0.y); w4.y = pk2(c0.z, c0.w); w4.z = pk2(c1.x, c1.y); w4.w = pk2(c1.z, c1.w); *(u32x4*)(CKVN + kvrow * 512 + lane * 8) = w4;
            KR[kvrow * 64 + lane] = krv;
            continue;
        }
        const bf16_t* z = Z + (size_t)r * INWP;
        const bool lat = r >= NCTXR;
        int b, t; size_t kvrow;
        if (!lat) { b = r >> 8; t = r & 255; kvrow = r; } else { const int q = r - NCTXR; b = q >> 10; t = q & 1023; kvrow = 8192 + (size_t)b * 1536 + 512 + t; }
        const size_t orow = ((size_t)(b * 2 + l) * 256 + t);
        u32x2 zq[3], zc[3], zk, zv, zra, zrb = (u32x2){0u, 0u}, zkr = (u32x2){0u, 0u};
#pragma unroll
        for (int j = 0; j < 3; ++j) { zq[j] = *(const u32x2*)(z + ZQB + 256 * j + 4 * lane); zc[j] = *(const u32x2*)(z + ZQC + 192 * (2 * j + hp) + 4 * m); }
        zk = *(const u32x2*)(z + ZKB + 4 * lane); zv = *(const u32x2*)(z + ZVB + 4 * lane);
        zra = *(const u32x2*)(z + ZQC + 192 * ht + 128 + 4 * mt);
        if (lane < 32) zrb = *(const u32x2*)(z + ZQC + 192 * (4 + ht) + 128 + 4 * mt);
        const u32x4 raw = *(const u32x4*)(z + ZCKV + lane * 8);
        if (lane < 16) zkr = *(const u32x2*)(z + ZKR + 4 * lane);
        asm volatile("" ::: "memory");
        float cg[4], sg[4], cc[4], sc[4];
#pragma unroll
        for (int e = 0; e < 4; ++e) { cg[e] = 1.f; sg[e] = 0.f; cc[e] = 1.f; sc[e] = 0.f; }
        if (lat) { const float pg = halfg ? (float)(t & 63) : (float)(t >> 6), pc = halfc ? (float)(t & 63) : (float)(t >> 6);
#pragma unroll
            for (int e = 0; e < 4; ++e) { cg[e] = __cosf(pg * invg[e]); sg[e] = __sinf(pg * invg[e]); cc[e] = __cosf(pc * invc[e]); sc[e] = __sinf(pc * invc[e]); } }
#pragma unroll
        for (int e = 0; e < 4; ++e) { if (!isx1) sg[e] = -sg[e]; if (!isx1c) sc[e] = -sc[e]; }
#pragma unroll
        for (int j = 0; j < 3; ++j) { float v[4] = {lo_bf(zq[j].x), hi_bf(zq[j].x), lo_bf(zq[j].y), hi_bf(zq[j].y)};
            const float rs_ = rowsum16((v[0] * v[0] + v[1] * v[1]) + (v[2] * v[2] + v[3] * v[3]));
            const float sa = rlf(rs_, 0) + rlf(rs_, 16), sb = rlf(rs_, 32) + rlf(rs_, 48);
            const float rs = rsqrtf((hp ? sb : sa) * (1.f / 128.f) + EPSN);
            float n[4], o[4];
#pragma unroll
            for (int e = 0; e < 4; ++e) n[e] = v[e] * rs * gq4[e];
#pragma unroll
            for (int e = 0; e < 4; ++e) o[e] = n[e] * cg[e] - ror8(n[e]) * sg[e];
            u32x2 w; w.x = pk2(o[0], o[1]); w.y = pk2(o[2], o[3]); *(u32x2*)(QB + (size_t)r * 768 + 256 * j + 4 * lane) = w; }
        { float v[4] = {lo_bf(zk.x), hi_bf(zk.x), lo_bf(zk.y), hi_bf(zk.y)};
            const float rs_ = rowsum16((v[0] * v[0] + v[1] * v[1]) + (v[2] * v[2] + v[3] * v[3]));
            const float sa = rlf(rs_, 0) + rlf(rs_, 16), sb = rlf(rs_, 32) + rlf(rs_, 48);
            const float rs = rsqrtf((hp ? sb : sa) * (1.f / 128.f) + EPSN);
            float n[4], o[4];
#pragma unroll
            for (int e = 0; e < 4; ++e) n[e] = v[e] * rs * gk4[e];
#pragma unroll
            for (int e = 0; e < 4; ++e) o[e] = n[e] * cg[e] - ror8(n[e]) * sg[e];
            u32x2 w; w.x = pk2(o[0], o[1]); w.y = pk2(o[2], o[3]); *(u32x2*)(KB + kvrow * 256 + 4 * lane) = w;
            *(u32x2*)(VB + kvrow * 256 + 4 * lane) = zv;
            if (!lat) { *(f32x4*)(a->out + O_K + orow * 256 + 4 * lane) = (f32x4){n[0], n[1], n[2], n[3]};
                        *(f32x4*)(a->out + O_V + orow * 256 + 4 * lane) = (f32x4){lo_bf(zv.x), hi_bf(zv.x), lo_bf(zv.y), hi_bf(zv.y)}; } }
        float vn[3][4], nope[6];
#pragma unroll
        for (int j = 0; j < 3; ++j) { vn[j][0] = lo_bf(zc[j].x); vn[j][1] = hi_bf(zc[j].x); vn[j][2] = lo_bf(zc[j].y); vn[j][3] = hi_bf(zc[j].y);
            const float rs_ = rowsum16((vn[j][0] * vn[j][0] + vn[j][1] * vn[j][1]) + (vn[j][2] * vn[j][2] + vn[j][3] * vn[j][3]));
            nope[2 * j] = rlf(rs_, 0) + rlf(rs_, 16); nope[2 * j + 1] = rlf(rs_, 32) + rlf(rs_, 48); }
        float ta[4] = {lo_bf(zra.x), hi_bf(zra.x), lo_bf(zra.y), hi_bf(zra.y)}, tb[4] = {lo_bf(zrb.x), hi_bf(zrb.x), lo_bf(zrb.y), hi_bf(zrb.y)};
        const float tsa = rowsum16((ta[0] * ta[0] + ta[1] * ta[1]) + (ta[2] * ta[2] + ta[3] * ta[3])), tsb = rowsum16((tb[0] * tb[0] + tb[1] * tb[1]) + (tb[2] * tb[2] + tb[3] * tb[3]));
        float rsh[6];
        rsh[0] = rsqrtf((nope[0] + rlf(tsa, 0)) * (1.f / 192.f) + EPSN); rsh[1] = rsqrtf((nope[1] + rlf(tsa, 16)) * (1.f / 192.f) + EPSN);
        rsh[2] = rsqrtf((nope[2] + rlf(tsa, 32)) * (1.f / 192.f) + EPSN); rsh[3] = rsqrtf((nope[3] + rlf(tsa, 48)) * (1.f / 192.f) + EPSN);
        rsh[4] = rsqrtf((nope[4] + rlf(tsb, 0)) * (1.f / 192.f) + EPSN); rsh[5] = rsqrtf((nope[5] + rlf(tsb, 16)) * (1.f / 192.f) + EPSN);
#pragma unroll
        for (int j = 0; j < 3; ++j) { const float rs = hp ? rsh[2 * j + 1] : rsh[2 * j];
            u32x2 w; w.x = pk2(vn[j][0] * rs * gcn4[0], vn[j][1] * rs * gcn4[1]); w.y = pk2(vn[j][2] * rs * gcn4[2], vn[j][3] * rs * gcn4[3]);
            *(u32x2*)(QC + (size_t)r * 1152 + 192 * (2 * j + hp) + 4 * m) = w; }
        { const float rsa = ht == 0 ? rsh[0] : ht == 1 ? rsh[1] : ht == 2 ? rsh[2] : rsh[3]; const float rsb = ht == 0 ? rsh[4] : rsh[5];
          float na[4], nb[4], oa[4], ob[4];
#pragma unroll
          for (int e = 0; e < 4; ++e) { na[e] = ta[e] * rsa * gcr4[e]; nb[e] = tb[e] * rsb * gcr4[e]; }
#pragma unroll
          for (int e = 0; e < 4; ++e) { oa[e] = na[e] * cc[e] - swz4(na[e]) * sc[e]; ob[e] = nb[e] * cc[e] - swz4(nb[e]) * sc[e]; }
          u32x2 w; w.x = pk2(oa[0], oa[1]); w.y = pk2(oa[2], oa[3]); *(u32x2*)(QC + (size_t)r * 1152 + 192 * ht + 128 + 4 * mt) = w;
          if (lane < 32) { w.x = pk2(ob[0], ob[1]); w.y = pk2(ob[2], ob[3]); *(u32x2*)(QC + (size_t)r * 1152 + 192 * (4 + ht) + 128 + 4 * mt) = w; } }
        { float x[8];
          x[0] = lo_bf(raw.x); x[1] = hi_bf(raw.x); x[2] = lo_bf(raw.y); x[3] = hi_bf(raw.y); x[4] = lo_bf(raw.z); x[5] = hi_bf(raw.z); x[6] = lo_bf(raw.w); x[7] = hi_bf(raw.w);
          float sq = 0.f;
#pragma unroll
          for (int j = 0; j < 8; ++j) sq += x[j] * x[j];
          const float rs = rsqrtf(wave_sum(sq) * (1.f / 512.f) + EPSN);
          const f32x4 y0 = (f32x4){x[0], x[1], x[2], x[3]} * rs * gkv0, y1 = (f32x4){x[4], x[5], x[6], x[7]} * rs * gkv1;
          u32x4 w4; w4.x = pk2(y0.x, y0.y); w4.y = pk2(y0.z, y0.w); w4.z = pk2(y1.x, y1.y); w4.w = pk2(y1.z, y1.w); *(u32x4*)(CKVN + kvrow * 512 + lane * 8) = w4;
          if (!lat) { *(f32x4*)(a->out + O_CKV + orow * 512 + lane * 8) = y0; *(f32x4*)(a->out + O_CKV + orow * 512 + lane * 8 + 4) = y1; } }
        if (lane < 16) { const f32x4 kv = (f32x4){lo_bf(zkr.x), hi_bf(zkr.x), lo_bf(zkr.y), hi_bf(zkr.y)}; *(f32x4*)(KR + kvrow * 64 + 4 * lane) = kv; if (!lat) *(f32x4*)(a->out + O_KRO + orow * 64 + 4 * lane) = kv; }
    }
}

__device__ __forceinline__ float lcst(float v) { asm volatile("" : "+v"(v)); return v; }
__device__ __forceinline__ void sincos_acc(float x, float& s, float& c) {
    const float k = rintf(x * 0.636619772367581343f);
    float r = fmaf(-k, 1.5703125f, x); r = fmaf(-k, 4.837512969970703125e-4f, r); r = fmaf(-k, 7.54978995489188e-8f, r);
    const float r2 = r * r;
    const float sr = fmaf(r * r2, fmaf(r2, fmaf(r2, lcst(-1.9515295891e-4f), lcst(8.3321608736e-3f)), lcst(-1.6666654611e-1f)), r);
    const float cr = fmaf(r2 * r2, fmaf(r2, fmaf(r2, lcst(2.443315711809948e-5f), lcst(-1.388731625493765e-3f)), lcst(4.166664568298827e-2f)), fmaf(r2, -0.5f, 1.0f));
    const int q = ((int)k) & 3;
    s = (q == 0) ? sr : (q == 1) ? cr : (q == 2) ? -sr : -cr;
    c = (q == 0) ? cr : (q == 1) ? -sr : (q == 2) ? -cr : sr;
}
constexpr int S5_HROW = 272;
constexpr int S5_BUROW = 528;
constexpr int S5_WLDS = 16 * S5_BUROW + 16 * S5_HROW;
__device__ __forceinline__ void s5_item(AP a, int l, int seq, int dir, int g, LAS unsigned char* wl, int lane) {
    const bool lat = seq >= 32; const int T = lat ? 1024 : 256; const int row0 = lat ? NCTXR + (seq - 32) * 1024 : seq * 256;
    const int pidx = (l * 2 + dir) * 32 + g;
    const bf16_t* Z = (const bf16_t*)(a->ws + WS_Z);
    float* Yd = (float*)(a->ws + (dir ? WS_YB : WS_YF));
    float lbr, lbi, cr, ci;
    { const float lr = a->in[21][pidx * 64 + lane], li = a->in[22][pidx * 64 + lane]; const float dt = expf(a->in[23][pidx]);
      const float ang = li * dt; float sn, cs, sh, ch; sincos_acc(ang, sn, cs); sincos_acc(0.5f * ang, sh, ch);
      const float em1 = expm1f(lr * dt), mag = em1 + 1.f;
      lbr = mag * cs; lbi = mag * sn;
      const float nr = em1 - 2.f * mag * sh * sh, ni = lbi, den = lr * lr + li * li; cr = (nr * lr + ni * li) / den; ci = (ni * lr - nr * li) / den; }
    bf16x8 ahi[8], alo[8];
    { const int ri = lane & 1, cb = 8 * ((lane >> 4) & 1); const bool act = lane < 32;
#pragma unroll
      for (int m = 0; m < 8; ++m) { const int pm = 8 * m + ((lane & 15) >> 1);
          const float crm = __shfl(cr, pm), cim = __shfl(ci, pm);
          const f32x4* bre = (const f32x4*)(a->in[24] + ((size_t)pidx * 64 + pm) * 16 + cb); const f32x4* bim = (const f32x4*)(a->in[25] + ((size_t)pidx * 64 + pm) * 16 + cb);
          float v[8];
#pragma unroll
          for (int j = 0; j < 2; ++j) { const f32x4 br = bre[j], bi = bim[j];
#pragma unroll
              for (int e = 0; e < 4; ++e) v[j * 4 + e] = act ? (ri ? crm * bi[e] + cim * br[e] : crm * br[e] - cim * bi[e]) : 0.f; }
          unsigned h[8], lo[8];
#pragma unroll
          for (int e = 0; e < 8; ++e) { h[e] = f2bf(v[e]); lo[e] = f2bf(v[e] - bf2f((unsigned short)h[e])); }
          u32x4 wh, wlw; wh.x = h[0] | (h[1] << 16); wh.y = h[2] | (h[3] << 16); wh.z = h[4] | (h[5] << 16); wh.w = h[6] | (h[7] << 16);
          wlw.x = lo[0] | (lo[1] << 16); wlw.y = lo[2] | (lo[3] << 16); wlw.z = lo[4] | (lo[5] << 16); wlw.w = lo[6] | (lo[7] << 16);
          ahi[m] = __builtin_bit_cast(bf16x8, wh); alo[m] = __builtin_bit_cast(bf16x8, wlw); } }
    bf16x8 cf[4];
    { const int cc = lane & 15;
#pragma unroll
      for (int kb = 0; kb < 4; ++kb) { const int p0 = 16 * kb + 4 * (lane >> 4);
          const f32x4 c_r = *(const f32x4*)(a->in[26] + ((size_t)pidx * 16 + cc) * 64 + p0), c_i = *(const f32x4*)(a->in[27] + ((size_t)pidx * 16 + cc) * 64 + p0);
          u32x4 w; w.x = pk2(c_r.x, -c_i.x); w.y = pk2(c_r.y, -c_i.y); w.z = pk2(c_r.z, -c_i.z); w.w = pk2(c_r.w, -c_i.w); cf[kb] = __builtin_bit_cast(bf16x8, w); } }
    float hr = 0.f, hi = 0.f;
    if (lat) { const f32x2 h0 = *(const f32x2*)(a->in[6] + (((((size_t)(seq - 32) * 2 + l) * 2 + dir) * 32 + g) * 64 + lane) * 2); hr = h0.x; hi = h0.y; }
    LAS unsigned char* BU = wl; LAS unsigned char* H = wl + 16 * S5_BUROW;
    const int ut = lane & 15, uh = (lane >> 4) & 1;
    auto urow = [&](int n) { return (size_t)(row0 + (dir ? T - 1 - n : n)); };
    u32x4 ureg = (u32x4){0u, 0u, 0u, 0u}, unext = (u32x4){0u, 0u, 0u, 0u};
    if (lane < 32) ureg = *(const u32x4*)(Z + urow(ut) * INWP + ZU + g * 16 + uh * 8);
    const int nch = T / 16;
    for (int ci_ = 0; ci_ < nch; ++ci_) {
        if (ci_ + 1 < nch && lane < 32) unext = *(const u32x4*)(Z + urow(16 * (ci_ + 1) + ut) * INWP + ZU + g * 16 + uh * 8);
        const bf16x8 ub = __builtin_bit_cast(bf16x8, ureg);
#pragma unroll
        for (int m = 0; m < 8; ++m) { f32x4 d = __builtin_amdgcn_mfma_f32_16x16x32_bf16(ahi[m], ub, (f32x4){0.f, 0.f, 0.f, 0.f}, 0, 0, 0);
            d = __builtin_amdgcn_mfma_f32_16x16x32_bf16(alo[m], ub, d, 0, 0, 0);
            *(LAS f32x4*)(BU + (lane & 15) * S5_BUROW + (16 * m + 4 * (lane >> 4)) * 4) = d; }
        asm volatile("" ::: "memory");
#pragma unroll
        for (int s = 0; s < 16; ++s) {
            const f32x2 b = *(const LAS f32x2*)(BU + s * S5_BUROW + lane * 8);
            const float nr = lbr * hr - lbi * hi + b.x, ni = lbr * hi + lbi * hr + b.y; hr = nr; hi = ni;
            *(LAS unsigned*)(H + s * S5_HROW + lane * 4) = pk2(hr, hi);
        }
        asm volatile("" ::: "memory");
        f32x4 acc = (f32x4){0.f, 0.f, 0.f, 0.f};
#pragma unroll
        for (int kb = 0; kb < 4; ++kb) { const bf16x8 hb = *(const LAS bf16x8*)(H + (lane & 15) * S5_HROW + (16 * kb + 4 * (lane >> 4)) * 4);
            acc = __builtin_amdgcn_mfma_f32_16x16x32_bf16(cf[kb], hb, acc, 0, 0, 0); }
        *(f32x4*)(Yd + ((size_t)g * NTOK + urow(16 * ci_ + (lane & 15))) * 16 + 4 * (lane >> 4)) = acc;
        asm volatile("" ::: "memory");
        ureg = unext;
    }
    if (!lat) { *(f32x2*)(a->out + O_SSM + (((((size_t)seq * 2 + l) * 2 + dir) * 32 + g) * 64 + lane) * 2) = (f32x2){hr, hi}; }
}
__device__ __forceinline__ void s5_phase(AP a, const Ctx& c, int l, LAS unsigned char* lds) {
    LAS unsigned char* wl = lds + c.wave * S5_WLDS;
    const int slot = c.wave * c.G + c.bx, nslots = NWAVES * c.G;
    if (nslots > 512 + 64) {
        if (slot < 512) { const int it = slot; s5_item(a, l, 32 + it / 64, (it % 64) >> 5, it & 31, wl, c.lane); }
        else { for (int j = slot - 512; j < 2048; j += nslots - 512) s5_item(a, l, j / 64, (j % 64) >> 5, j & 31, wl, c.lane); }
    } else {
        for (int it = slot; it < 2560; it += nslots) { int seq, rem; if (it < 512) { seq = 32 + it / 64; rem = it % 64; } else { const int j = it - 512; seq = j / 64; rem = j % 64; }
            s5_item(a, l, seq, rem >> 5, rem & 31, wl, c.lane); }
    }
}

__device__ __forceinline__ void knorm_combine(AP a, const Ctx& c, int l) {
    const bf16_t* KVRAW = (const bf16_t*)(a->ws + WS_KVRAW); const float* KR = (const float*)(a->ws + WS_KR); bf16_t* KC = (bf16_t*)(a->ws + WS_KC);
    const int lane = c.lane;
    const int halfc = (lane >> 4) & 1; const bool isx1c = (lane & 8) == 0; const int ibc = 2 * (lane & 7);
    const float inv64_0 = __builtin_amdgcn_exp2f(-(float)ibc * (L2_10000 / 16.f)), inv64_1 = __builtin_amdgcn_exp2f(-(float)(ibc + 1) * (L2_10000 / 16.f));
    const f32x2 gn = *(const f32x2*)(a->in[18] + l * 192 + 2 * lane);
    const f32x2 gr = lane < 32 ? *(const f32x2*)(a->in[18] + l * 192 + 128 + 2 * lane) : (f32x2){0.f, 0.f};
    unsigned kkn[6]; f32x2 krn = (f32x2){0.f, 0.f};
    if (c.gw < KVROWS) { const bf16_t* kn = KVRAW + (size_t)c.gw * 1536;
#pragma unroll
        for (int hh = 0; hh < 6; ++hh) kkn[hh] = *(const unsigned*)(kn + hh * 128 + 2 * lane);
        if (lane < 32) krn = *(const f32x2*)(KR + (size_t)c.gw * 64 + 2 * lane); }
    for (int r = c.gw; r < KVROWS; r += c.NGW) {
        bool isnew = false; int t = 0;
        if (r >= 8192) { const int q = (r - 8192) % 1536; if (q >= 512) { isnew = true; t = q - 512; } }
        unsigned kk[6]; f32x2 kr2 = krn;
#pragma unroll
        for (int hh = 0; hh < 6; ++hh) kk[hh] = kkn[hh];
        if (r + c.NGW < KVROWS) { const bf16_t* kn = KVRAW + (size_t)(r + c.NGW) * 1536;
#pragma unroll
            for (int hh = 0; hh < 6; ++hh) kkn[hh] = *(const unsigned*)(kn + hh * 128 + 2 * lane);
            if (lane < 32) krn = *(const f32x2*)(KR + (size_t)(r + c.NGW) * 64 + 2 * lane); }
        asm volatile("" ::: "memory");
        float c60 = 1.f, s60 = 0.f, c61 = 1.f, s61 = 0.f;
        if (isnew) { const float pc = halfc ? (float)(t & 63) : (float)(t >> 6); c60 = __cosf(pc * inv64_0); s60 = __sinf(pc * inv64_0); c61 = __cosf(pc * inv64_1); s61 = __sinf(pc * inv64_1); }
        if (!isx1c) { s60 = -s60; s61 = -s61; }
        const float sskr = wave_sum(kr2.x * kr2.x + kr2.y * kr2.y);
#pragma unroll
        for (int hh = 0; hh < 6; ++hh) { const float va = lo_bf(kk[hh]), vb = hi_bf(kk[hh]);
            const float rs = rsqrtf((wave_sum(va * va + vb * vb) + sskr) * (1.f / 192.f) + EPSN);
            bf16_t* ko = KC + (size_t)r * 1152 + hh * 192;
            *(unsigned*)(ko + 2 * lane) = pk2(va * rs * gn.x, vb * rs * gn.y);
            const float n0 = kr2.x * rs * gr.x, n1 = kr2.y * rs * gr.y; const float p0 = swz8(n0), p1 = swz8(n1);
            if (lane < 32) *(unsigned*)(ko + 128 + 2 * lane) = pk2(n0 * c60 - p0 * s60, n1 * c61 - p1 * s61); }
    }
    const bf16_t* Z = (const bf16_t*)(a->ws + WS_Z); const float* YF = (const float*)(a->ws + WS_YF); const float* YB = (const float*)(a->ws + WS_YB); bf16_t* Y = (bf16_t*)(a->ws + WS_Y);
    const f32x4 d0 = *(const f32x4*)(a->in[28] + l * 512 + lane * 8), d1 = *(const f32x4*)(a->in[28] + l * 512 + lane * 8 + 4);
    for (int r = c.gw; r < NTOK; r += c.NGW) {
        const u32x4 raw = *(const u32x4*)(Z + (size_t)r * INWP + ZU + lane * 8);
        const f32x4 u0 = (f32x4){__builtin_bit_cast(float, raw.x << 16), __builtin_bit_cast(float, raw.x & 0xffff0000u), __builtin_bit_cast(float, raw.y << 16), __builtin_bit_cast(float, raw.y & 0xffff0000u)};
        const f32x4 u1 = (f32x4){__builtin_bit_cast(float, raw.z << 16), __builtin_bit_cast(float, raw.z & 0xffff0000u), __builtin_bit_cast(float, raw.w << 16), __builtin_bit_cast(float, raw.w & 0xffff0000u)};
        const size_t yo = ((size_t)(lane >> 1) * NTOK + r) * 16 + (lane & 1) * 8;
        const f32x4 f0 = *(const f32x4*)(YF + yo), f1 = *(const f32x4*)(YF + yo + 4);
        const f32x4 b0 = *(const f32x4*)(YB + yo), b1 = *(const f32x4*)(YB + yo + 4);
        const f32x4 y0 = d0 * u0 + f0 + b0, y1 = d1 * u1 + f1 + b1;
        u32x4 w; w.x = pk2(y0.x, y0.y); w.y = pk2(y0.z, y0.w); w.z = pk2(y1.x, y1.y); w.w = pk2(y1.z, y1.w); *(u32x4*)(Y + (size_t)r * 512 + lane * 8) = w;
    }
}

template <bool MLA>
__device__ __forceinline__ void attn_unit_run(AP a, int u, char* lds, const int tid) {
    int seq, h, qb;
    if (u < 192) { seq = 32 + u / 24; h = (u % 24) >> 2; qb = u & 3; } else { const int j = u - 192; seq = j / 6; h = j % 6; qb = 0; }
    const bool lat = seq >= 32;
    const size_t qrow = lat ? NCTXR + (size_t)(seq - 32) * 1024 + qb * 256 : (size_t)seq * 256;
    const size_t kvrow = lat ? 8192 + (size_t)(seq - 32) * 1536 : (size_t)seq * 256;
    const int nkeys = lat ? 1536 : 256;
    bf16_t* MIX = (bf16_t*)(a->ws + WS_MIX);
    if constexpr (!MLA) {
        const bf16_t* Q = (const bf16_t*)(a->ws + WS_QB) + qrow * 768 + h * 128;
        const bf16_t* K = (const bf16_t*)(a->ws + WS_KB) + kvrow * 256 + (h / 3) * 128;
        const bf16_t* V = (const bf16_t*)(a->ws + WS_VB) + kvrow * 256 + (h / 3) * 128;
        att::attn_body<128, 768, 256, 256>(Q, K, V, MIX + qrow * 2048 + 512 + h * 128, nkeys, lds, tid);
    } else {
        const bf16_t* Q = (const bf16_t*)(a->ws + WS_QC) + qrow * 1152 + h * 192;
        const bf16_t* K = (const bf16_t*)(a->ws + WS_KC) + kvrow * 1152 + h * 192;
        const bf16_t* V = (const bf16_t*)(a->ws + WS_KVRAW) + kvrow * 1536 + 768 + h * 128;
        att::attn_body<192, 1152, 1152, 1536>(Q, K, V, MIX + qrow * 2048 + 1280 + h * 128, nkeys, lds, tid);
    }
}
template <bool MLA>
__device__ __forceinline__ void attn_phase(AP a, const Ctx& c, char* lds) {
    const int bx = c.vc;
    int u0, du, nu;
    if (c.G == 256) { if (bx < 192) { u0 = bx; du = 1; nu = 1; } else { u0 = 192 + 3 * (bx - 192); du = 1; nu = 3; } }
    else { u0 = bx; du = c.G; nu = (384 - bx + c.G - 1) / c.G; }
#pragma unroll 1
    for (int k = 0; k < nu; ++k) attn_unit_run<MLA>(a, u0 + k * du, lds, c.tid);
}

__global__ void __launch_bounds__(NTHR, 2) fwd_megakernel(Args kargs_unused) {
    extern __shared__ __attribute__((aligned(16))) unsigned char lds_raw[];
    cg::grid_group grid = cg::this_grid();
    LAS unsigned char* lds = (LAS unsigned char*)lds_raw;
    Ctx c;
    AP a = (AP)__builtin_amdgcn_kernarg_segment_ptr();
    const int wave_id0 = __builtin_amdgcn_readfirstlane((int)threadIdx.x >> 6);
#define PHASE_BEGIN() do { int w_ = wave_id0; asm volatile("" : "+s"(w_)); int ln_; asm volatile("v_mbcnt_lo_u32_b32 %0, -1, 0\n\tv_mbcnt_hi_u32_b32 %0, -1, %0" : "=v"(ln_)); \
        int b_ = blockIdx.x; asm volatile("" : "+s"(b_)); int g_ = gridDim.x; asm volatile("" : "+s"(g_)); \
        c.tid = w_ * 64 + ln_; c.lane = ln_; c.wave = w_; c.G = g_; c.bx = b_; c.gw = b_ * NWAVES + w_; c.NGW = g_ * NWAVES; asm volatile("" : "+s"(a)); \
        c.xp = __builtin_amdgcn_readfirstlane((int)((volatile LAS unsigned*)(lds + 131072))[0]); c.xn = __builtin_amdgcn_readfirstlane((int)((volatile LAS unsigned*)(lds + 131072))[1]); \
        c.xr = __builtin_amdgcn_readfirstlane((int)((volatile LAS unsigned*)(lds + 131072))[2]); c.vc = c.xp + c.xr; } while (0)
#define GRID_SYNC() do { asm volatile("s_waitcnt vmcnt(0) lgkmcnt(0)" ::: "memory"); grid.sync(); \
        if (wave_id0 == 0) { __builtin_amdgcn_fence(__ATOMIC_ACQUIRE, "agent"); asm volatile("s_waitcnt vmcnt(0)" ::: "memory"); } \
        __syncthreads(); } while (0)
    unsigned nbar = 0u;
#define XB_SYNC() do { asm volatile("s_waitcnt vmcnt(0) lgkmcnt(0)" ::: "memory"); __syncthreads(); \
        if (threadIdx.x == 0) { volatile LAS unsigned* mz_ = (volatile LAS unsigned*)(lds + 131072); const unsigned x_ = mz_[4], nx_ = mz_[5], nloc_ = mz_[6]; \
            AP a2_ = a; asm volatile("" : "+s"(a2_)); unsigned* xb_ = (unsigned*)(a2_->ws + WS_XB); \
            const unsigned old_ = __hip_atomic_fetch_add(xb_ + 64u * x_, 1u, __ATOMIC_RELAXED, __HIP_MEMORY_SCOPE_AGENT); \
            if (old_ + 1u == (nbar + 1u) * nloc_) { \
                __builtin_amdgcn_fence(__ATOMIC_RELEASE, "agent"); asm volatile("s_waitcnt vmcnt(0)" ::: "memory"); \
                const unsigned og_ = __hip_atomic_fetch_add(xb_ + 2048, 1u, __ATOMIC_RELAXED, __HIP_MEMORY_SCOPE_AGENT); \
                if (og_ + 1u == (nbar + 1u) * nx_) (void)__hip_atomic_fetch_add(xb_ + 2112, 1u, __ATOMIC_RELAXED, __HIP_MEMORY_SCOPE_AGENT); \
                else while (__hip_atomic_load(xb_ + 2112, __ATOMIC_RELAXED, __HIP_MEMORY_SCOPE_AGENT) == nbar) __builtin_amdgcn_s_sleep(1); \
                __builtin_amdgcn_fence(__ATOMIC_ACQUIRE, "agent"); \
                (void)__hip_atomic_fetch_add(xb_ + 1024u + 64u * x_, 1u, __ATOMIC_RELAXED, __HIP_MEMORY_SCOPE_AGENT); asm volatile("s_waitcnt vmcnt(0)" ::: "memory"); \
            } else { \
                while (__hip_atomic_load(xb_ + 1024u + 64u * x_, __ATOMIC_RELAXED, __HIP_MEMORY_SCOPE_AGENT) == nbar) __builtin_amdgcn_s_sleep(1); \
                __builtin_amdgcn_fence(__ATOMIC_ACQUIRE, "agent"); asm volatile("s_waitcnt vmcnt(0)" ::: "memory"); } } \
        nbar += 1u; __syncthreads(); } while (0)
    PHASE_BEGIN();

#ifndef PH
#define PH 0xFFFF
#endif
#if PH & 1
    if (blockIdx.x == 0 && threadIdx.x < 16) ((unsigned*)(a->ws + WS_CEN))[threadIdx.x] = 0u;
    if (blockIdx.x == 0) for (int i = threadIdx.x; i < 2176; i += NTHR) ((unsigned*)(a->ws + WS_XB))[i] = 0u;
    phase0(a, c, lds);
#endif
    GRID_SYNC(); PHASE_BEGIN();
    { volatile LAS unsigned* misc = (volatile LAS unsigned*)(lds + 131072);
      if (c.tid == 0) { unsigned* cen = (unsigned*)(a->ws + WS_CEN); const unsigned x = (unsigned)__builtin_amdgcn_s_getreg((3 << 11) | 20) & 0xFu;
          misc[2] = x; misc[3] = __hip_atomic_fetch_add(cen + x, 1u, __ATOMIC_RELAXED, __HIP_MEMORY_SCOPE_AGENT); }
      GRID_SYNC();
      if (threadIdx.x == 0) { unsigned* cen = (unsigned*)(a->ws + WS_CEN); const unsigned x = misc[2], rank = misc[3]; unsigned pre = 0u, mine = 1u, tot = 0u;
          for (unsigned j = 0; j < 16; ++j) { const unsigned v = __hip_atomic_load(cen + j, __ATOMIC_RELAXED, __HIP_MEMORY_SCOPE_AGENT); tot += v; if (j < x) pre += v; if (j == x) mine = v; }
          if (tot != gridDim.x || rank >= mine) { pre = blockIdx.x; mine = 1u; }
          unsigned nxp = 0u; for (unsigned j = 0; j < 16; ++j) nxp += __hip_atomic_load(cen + j, __ATOMIC_RELAXED, __HIP_MEMORY_SCOPE_AGENT) ? 1u : 0u;
          const bool bad = (tot != gridDim.x || rank >= mine);
          misc[0] = pre; misc[1] = mine; misc[2] = bad ? 0u : rank; misc[4] = x; misc[5] = bad ? 0u : nxp; misc[6] = bad ? 1u : mine; }
      __syncthreads(); PHASE_BEGIN(); }

    const bool use_xb = __builtin_amdgcn_readfirstlane((int)((volatile LAS unsigned*)(lds + 131072))[5]) != 0;
#define SEAM() do { if (use_xb) XB_SYNC(); else GRID_SYNC(); } while (0)
#pragma unroll
    for (int l = 0; l < 2; ++l) {
        const bool first = (l == 0);
#define WLP (a->ws + WS_W + (size_t)l * WL_SIZE)
#if PH & 2
        phase_norm(a, c, l, 0, first);
#endif
        SEAM(); PHASE_BEGIN();
#if PH & 4
        { pg8::Gemm g{(const bf16_t*)(a->ws + WS_HN), (const bf16_t*)(WLP + WL_IN), NTOK, INWP, DM}; pg8::StaticOrder S; S.init(NTOK, INWP, c.G, c.xp, c.xn, c.xr);
          pg8::EpiBf16<0> E{(bf16_t*)(a->ws + WS_Z), INWP};
          pg8::gemm_phase<pg8::EpiBf16<0>, pg8::StaticOrder, true, true>(lds, g, S, E, c.tid); }
        SEAM(); PHASE_BEGIN();
#endif
#if PH & 8
        s5_phase(a, c, l, lds);
#endif
        PHASE_BEGIN();
#if PH & 16
        zpost_rows(a, c, l);
#endif
        SEAM(); PHASE_BEGIN();
#if PH & 32
        { pg8::Gemm g{(const bf16_t*)(a->ws + WS_CKVN), (const bf16_t*)(WLP + WL_UKV), KVROWS, 1536, 512}; pg8::StaticOrder S; S.init(KVROWS, 1536, c.G, c.xp, c.xn, c.xr);
          pg8::EpiBf16<0> E{(bf16_t*)(a->ws + WS_KVRAW), 1536};
          pg8::gemm_phase<pg8::EpiBf16<0>, pg8::StaticOrder, true, true>(lds, g, S, E, c.tid); }
#endif
        __syncthreads(); PHASE_BEGIN();
#if PH & 64
        attn_phase<false>(a, c, (char*)lds_raw);
#endif
        SEAM(); PHASE_BEGIN();
#if PH & 128
        knorm_combine(a, c, l);
#endif
        SEAM(); PHASE_BEGIN();
#if PH & 256
        attn_phase<true>(a, c, (char*)lds_raw);
#endif
        __syncthreads(); PHASE_BEGIN();
#if PH & 512
        { pg8::Gemm g{(const bf16_t*)(a->ws + WS_Y), (const bf16_t*)(WLP + WL_GLU), NTOK, 1024, 512}; pg8::StaticOrder S; S.init(NTOK, 1024, c.G, c.xp, c.xn, c.xr);
          pg8::EpiGlu E{(bf16_t*)(a->ws + WS_MIX), DM};
          pg8::gemm_phase<pg8::EpiGlu, pg8::StaticOrder, true, true>(lds, g, S, E, c.tid); }
        SEAM(); PHASE_BEGIN();
#endif
#if PH & 1024
        { pg8::Gemm g{(const bf16_t*)(a->ws + WS_MIX), (const bf16_t*)(WLP + WL_OUT), NTOK, DM, DM}; pg8::StaticOrder S; S.init(NTOK, DM, c.G, c.xp, c.xn, c.xr);
          pg8::EpiResGate E{first ? a->in[0] : a->out, first ? a->in[1] : a->out + (size_t)NCTXR * DM, a->out, (const float*)(a->ws + WS_MOD) + (size_t)l * 9 * 12288 + 2 * DM};
          pg8::gemm_phase<pg8::EpiResGate, pg8::StaticOrder, true, true>(lds, g, S, E, c.tid); }
        SEAM(); PHASE_BEGIN();
#endif
#if PH & 2048
        phase_norm(a, c, l, 1, false);
#endif
        SEAM(); PHASE_BEGIN();
#if PH & 4096
        { pg8::Gemm g{(const bf16_t*)(a->ws + WS_HN), (const bf16_t*)(WLP + WL_FF1), NTOK, DFF, DM}; pg8::StaticOrder S; S.init(NTOK, DFF, c.G, c.xp, c.xn, c.xr);
          pg8::EpiBf16<2> E{(bf16_t*)(a->ws + WS_HFF), DFF};
          pg8::gemm_phase<pg8::EpiBf16<2>, pg8::StaticOrder, true, true>(lds, g, S, E, c.tid); }
        SEAM(); PHASE_BEGIN();
#endif
#if PH & 8192
        { pg8::Gemm g{(const bf16_t*)(a->ws + WS_HFF), (const bf16_t*)(WLP + WL_FF2), NTOK, DM, DFF}; pg8::StaticOrder S; S.init(NTOK, DM, c.G, c.xp, c.xn, c.xr);
          pg8::EpiResGate E{a->out, a->out + (size_t)NCTXR * DM, a->out, (const float*)(a->ws + WS_MOD) + (size_t)l * 9 * 12288 + 5 * DM};
          pg8::gemm_phase<pg8::EpiResGate, pg8::StaticOrder, true, true>(lds, g, S, E, c.tid); }
#endif
        if (l == 0) { SEAM(); PHASE_BEGIN(); }
    }
}

extern "C" void kernel_launch(void* const* d_in, const int* in_sizes, int n_in, void* d_out, int out_size, void* d_ws, size_t ws_size, hipStream_t stream) {
    static int grid_blocks = 0;
    if (grid_blocks == 0) {
        if (n_in != 33 || ws_size < WS_END) { fprintf(stderr, "kernel_launch: unexpected n_in %d / ws_size %zu (need %zu)\n", n_in, ws_size, (size_t)WS_END); grid_blocks = -1; return; }
        int dev = 0, cus = 0, per_cu = 0;
        hipGetDevice(&dev);
        hipDeviceGetAttribute(&cus, hipDeviceAttributeMultiprocessorCount, dev);
        if (hipFuncSetAttribute((const void*)fwd_megakernel, hipFuncAttributeMaxDynamicSharedMemorySize, LDS_BYTES) != hipSuccess) { fprintf(stderr, "kernel_launch: hipFuncSetAttribute failed\n"); grid_blocks = -1; return; }
        hipOccupancyMaxActiveBlocksPerMultiprocessor(&per_cu, (const void*)fwd_megakernel, NTHR, LDS_BYTES);
        if (per_cu < 1) per_cu = 1;
        grid_blocks = cus * per_cu;
        (void)hipGetLastError();
    }
    if (grid_blocks < 0) return;
    Args a{};
    for (int i = 0; i < 33; ++i) a.in[i] = (const float*)d_in[i];
    a.out = (float*)d_out; a.ws = (unsigned char*)d_ws;
    void* args[] = {&a};
    hipError_t e = hipLaunchCooperativeKernel((const void*)fwd_megakernel, dim3(grid_blocks), dim3(NTHR), args, LDS_BYTES, stream);
    if (e != hipSuccess) fprintf(stderr, "cooperative launch failed: %s (grid %d)\n", hipGetErrorString(e), grid_blocks);
}
```

```cpp
#include <hip/hip_runtime.h>
#include <hip/hip_bf16.h>
#include <hip/hip_cooperative_groups.h>
#include <cstdio>
#include <cstdint>
namespace cg = cooperative_groups;

#define LAS __attribute__((address_space(3)))
typedef unsigned short bf16_t;
typedef short bf16x8 __attribute__((ext_vector_type(8)));
typedef short s16x4 __attribute__((ext_vector_type(4)));
typedef float f32x4 __attribute__((ext_vector_type(4)));
typedef float f32x2 __attribute__((ext_vector_type(2)));
typedef float f32x16 __attribute__((ext_vector_type(16)));
typedef unsigned u32x4 __attribute__((ext_vector_type(4)));
typedef unsigned u32x2 __attribute__((ext_vector_type(2)));

constexpr int DM = 2048, DFF = 8192, NTOK = 16384, NCTXR = 8192;
constexpr int INW = 3520, INWP = 3584, KVROWS = 20480;
constexpr float EPSN = 1e-6f;
constexpr int ZU = 0, ZQB = 512, ZKB = 1280, ZVB = 1536, ZQC = 1792, ZCKV = 2944, ZKR = 3456;
constexpr size_t O_K = 33554432, O_V = 37748736, O_CKV = 41943040, O_KRO = 50331648, O_SSM = 51380224;
constexpr size_t MiB = 1u << 20;
constexpr size_t WS_XB = 902144;
constexpr size_t WS_CEN = 901120;
constexpr size_t WS_MOD = 0;
constexpr size_t WS_W = 1 * MiB;
constexpr size_t WL_IN = 0, WL_OUT = 14 * MiB, WL_FF1 = 22 * MiB, WL_FF2 = 54 * MiB, WL_GLU = 86 * MiB, WL_UKV = 87 * MiB, WL_SIZE = 89 * MiB;
constexpr size_t WS_HN = WS_W + 2 * WL_SIZE;
constexpr size_t WS_Z = WS_HN + 64 * MiB;
constexpr size_t WS_QB = WS_Z + 112 * MiB;
constexpr size_t WS_KB = WS_QB + 24 * MiB;
constexpr size_t WS_VB = WS_KB + 10 * MiB;
constexpr size_t WS_QC = WS_VB + 10 * MiB;
constexpr size_t WS_CKVN = WS_QC + 36 * MiB;
constexpr size_t WS_KR = WS_CKVN + 20 * MiB;
constexpr size_t WS_KVRAW = WS_KR + 5 * MiB;
constexpr size_t WS_KC = WS_KVRAW + 60 * MiB;
constexpr size_t WS_YF = WS_KC + 45 * MiB;
constexpr size_t WS_YB = WS_YF + 32 * MiB;
constexpr size_t WS_Y = WS_YB + 32 * MiB;
constexpr size_t WS_MIX = WS_Y + 16 * MiB;
constexpr size_t WS_END = WS_MIX + 64 * MiB;
constexpr size_t WS_HFF = WS_Z;
static_assert(WS_HFF + 256 * MiB <= WS_END, "hff overlay");
static_assert(WS_END <= 768 * MiB, "workspace");

struct Args {
    const float* in[33];
    float* out;
    unsigned char* ws;
};
typedef const __attribute__((address_space(4))) Args* AP;
#define RELOAD_ARGS() asm volatile("" : "+s"(a))

__device__ __forceinline__ unsigned f2bf(float f) { unsigned u = __builtin_bit_cast(unsigned, f); return (u + 0x7fffu + ((u >> 16) & 1u)) >> 16; }
__device__ __forceinline__ unsigned pk2(float lo, float hi) { unsigned r; asm("v_cvt_pk_bf16_f32 %0, %1, %2" : "=v"(r) : "v"(lo), "v"(hi)); return r; }
__device__ __forceinline__ float bf2f(unsigned short h) { return __builtin_bit_cast(float, (unsigned)h << 16); }
__device__ __forceinline__ float dpp_f(float v, const int ctrl_sel) {
    const int x = __builtin_bit_cast(int, v); int r;
    if (ctrl_sel == 0) r = __builtin_amdgcn_mov_dpp(x, 0xB1, 0xF, 0xF, true);
    else if (ctrl_sel == 1) r = __builtin_amdgcn_mov_dpp(x, 0x4E, 0xF, 0xF, true);
    else if (ctrl_sel == 2) r = __builtin_amdgcn_mov_dpp(x, 0x141, 0xF, 0xF, true);
    else r = __builtin_amdgcn_mov_dpp(x, 0x140, 0xF, 0xF, true);
    return __builtin_bit_cast(float, r);
}
__device__ __forceinline__ float wave_sum(float v) {
    v += dpp_f(v, 0); v += dpp_f(v, 1); v += dpp_f(v, 2); v += dpp_f(v, 3);
    v += __builtin_bit_cast(float, __builtin_amdgcn_ds_swizzle(__builtin_bit_cast(int, v), 0x401F));
    { auto rr = __builtin_amdgcn_permlane32_swap(__float_as_uint(v), __float_as_uint(v), false, false); v = __uint_as_float(rr[0]) + __uint_as_float(rr[1]); }
    return v;
}

namespace pg8 {
#define PG8_LAS __attribute__((address_space(3)))
constexpr int BM = 256, BK = 64, HALF = 128, HTB = HALF * BK * 2, STAGE_BYTES = 8 * HTB, NXCD = 8, WGM = 8;

__host__ __device__ __forceinline__ int lds_byte(int r, int c) { const int st = (r >> 4) * 2 + (c >> 5), rr = r & 15, cc = c & 31, ob = rr * 64 + cc * 2; return st * 1024 + (ob ^ (((ob >> 9) & 1) << 5)); }
__host__ __device__ __forceinline__ void stage_rc(int b, int& R, int& C) { const int st = b / 1024, sb = b % 1024, swz = sb ^ (((sb >> 9) & 1) << 5); R = (st >> 1) * 16 + swz / 64; C = (st & 1) * 32 + (swz % 64) / 2; }
__host__ __device__ __forceinline__ int perm32(int rho) { const int n = rho >> 4, i = rho & 15; return 8 * (i >> 2) + 4 * n + (i & 3); }

struct Unit { int pm, pn; };
struct Gemm { const bf16_t* A; const bf16_t* Bt; int M, N, K; };

struct StaticOrder {
    int nM, nN, nwg, start, end, xn, xr;
    __host__ __device__ void init(int M, int N, int G, int xp, int xn_, int xr_) { nM = M / BM; nN = N / BM; nwg = nM * nN; xn = xn_; xr = xr_;
        start = (int)((long)nwg * xp / G); end = (int)((long)nwg * (xp + xn_) / G); }
    __host__ __device__ bool next(int i, Unit& u) const {
        const int wgid = start + i * xn + xr; if (wgid >= end) return false;
        const int nig = WGM * nN, gid = wgid / nig, fm = gid * WGM, gsz = (nM - fm) < WGM ? (nM - fm) : WGM;
        u.pm = fm + ((wgid % nig) % gsz); u.pn = (wgid % nig) / gsz; return true;
    }
    __device__ __forceinline__ void a_ready(const Unit&) const {}
    __device__ __forceinline__ void done(const Unit&) const {}
};

template <int ACT  > struct EpiBf16 {
    static constexpr bool PERM = true, AFTER_DRAIN = false;
    bf16_t* O; int ldc;
    __device__ __forceinline__ void operator()(const f32x4 (&acc)[2][2][4][2], const Unit& u, int wr, int wc, int fr, int fq) const {
        const int row0 = u.pm * BM + wr * 64 + fr; const int col0 = u.pn * BM + wc * 32 + 8 * fq;
#pragma unroll
        for (int ai = 0; ai < 2; ++ai)
#pragma unroll
            for (int m = 0; m < 4; ++m) { bf16_t* rowp = O + (size_t)(row0 + ai * HALF + m * 16) * ldc + col0;
#pragma unroll
                for (int bj = 0; bj < 2; ++bj) { f32x4 v0 = acc[ai][bj][m][0], v1 = acc[ai][bj][m][1];
                    if (ACT == 2) {
#pragma unroll
                        for (int j = 0; j < 4; ++j) { float a = fmaxf(v0[j], 0.f), b = fmaxf(v1[j], 0.f); v0[j] = a * a; v1[j] = b * b; } }
                    u32x4 w; w.x = pk2(v0[0], v0[1]); w.y = pk2(v0[2], v0[3]); w.z = pk2(v1[0], v1[1]); w.w = pk2(v1[2], v1[3]);
                    *(u32x4*)(rowp + bj * HALF) = w; } }
    }
};
struct EpiGlu {
    static constexpr bool PERM = true, AFTER_DRAIN = false;
    bf16_t* O; int ldc;
    __device__ __forceinline__ void operator()(const f32x4 (&acc)[2][2][4][2], const Unit& u, int wr, int wc, int fr, int fq) const {
        const int row0 = u.pm * BM + wr * 64 + fr; const int col0 = u.pn * HALF + wc * 32 + 8 * fq;
#pragma unroll
        for (int ai = 0; ai < 2; ++ai)
#pragma unroll
            for (int m = 0; m < 4; ++m) { bf16_t* rowp = O + (size_t)(row0 + ai * HALF + m * 16) * ldc + col0;
                float o[8];
#pragma unroll
                for (int n = 0; n < 2; ++n)
#pragma unroll
                    for (int j = 0; j < 4; ++j) { const float a = acc[ai][0][m][n][j], g = acc[ai][1][m][n][j]; o[n * 4 + j] = a / (1.f + __expf(-g)); }
                u32x4 w; w.x = pk2(o[0], o[1]); w.y = pk2(o[2], o[3]); w.z = pk2(o[4], o[5]); w.w = pk2(o[6], o[7]);
                *(u32x4*)rowp = w; }
    }
};
struct EpiResGate {
    static constexpr bool PERM = false, AFTER_DRAIN = false;
    const float* xin0; const float* xin1; float* out; const float* gate;
    __device__ __forceinline__ void operator()(const f32x4 (&acc)[2][2][4][2], const Unit& u, int wr, int wc, int fr, int fq) const {
        const int rowt = u.pm * BM; const int set = rowt < NCTXR ? 0 : 1 + ((rowt - NCTXR) >> 10);
        const float* gp = gate + (size_t)set * 12288 + u.pn * BM + wc * 32 + 4 * fq;
        const float* xb = rowt < NCTXR ? xin0 + (size_t)rowt * DM : xin1 + (size_t)(rowt - NCTXR) * DM;
        f32x4 gv[2][2];
#pragma unroll
        for (int bj = 0; bj < 2; ++bj)
#pragma unroll
            for (int n = 0; n < 2; ++n) gv[bj][n] = *(const f32x4*)(gp + bj * HALF + n * 16);
#pragma unroll
        for (int ai = 0; ai < 2; ++ai)
#pragma unroll
            for (int m = 0; m < 4; ++m) { const int rl = ai * HALF + wr * 64 + m * 16 + fr; const size_t off = (size_t)rl * DM + u.pn * BM + wc * 32 + 4 * fq;
#pragma unroll
                for (int bj = 0; bj < 2; ++bj)
#pragma unroll
                    for (int n = 0; n < 2; ++n) { const f32x4 xv = *(const f32x4*)(xb + off + bj * HALF + n * 16);
                        *(f32x4*)(out + (size_t)rowt * DM + off + bj * HALF + n * 16) = xv + gv[bj][n] * acc[ai][bj][m][n]; } }
    }
};

template <class Epi, class Sched, bool ALIGN_EPI = false, bool SP2 = false>
__device__ __forceinline__ void gemm_phase(PG8_LAS unsigned char* lds, const Gemm g, const Sched& S, const Epi& E, const int tid) {
    const int wid = __builtin_amdgcn_readfirstlane(tid >> 6), lane = tid & 63, wr = wid >> 2, wc = wid & 3, fr = lane & 15, fq = lane >> 4;
    const int K = g.K, nt = K / BK;
    unsigned voffA[2], voffB[2];
#pragma unroll
    for (int i = 0; i < 2; ++i) { int R, C; stage_rc(tid * 16 + i * 8192, R, C); const int Rb = Epi::PERM ? ((R & ~31) + perm32(R & 31)) : R;
        voffA[i] = (unsigned)(R * K + C) * 2u; voffB[i] = (unsigned)(Rb * K + C) * 2u; }
    const size_t kstep = (size_t)(BK * 2);
    const size_t hstep = (size_t)HALF * K * 2;
    const size_t tstep = 2 * hstep;
    const unsigned ldsw = (unsigned)wid * 1024u;
    const int aoff = lds_byte(wr * 64 + fr, fq * 8), boff = lds_byte(wc * 32 + fr, fq * 8);
#define PG8_SA(b, h) (((b) * 2 + (h)) * HTB)
#define PG8_SB(b, h) ((4 + (b) * 2 + (h)) * HTB)
#define PG8_STAGE(bufoff, gbase, voff) do { _Pragma("unroll") for (int _i = 0; _i < 2; ++_i) \
        __builtin_amdgcn_global_load_lds((const unsigned*)((const char*)(gbase) + (voff)[_i]), (PG8_LAS unsigned*)(lds + (bufoff) + ldsw + _i * 8192), 16, 0, 0); } while (0)
#define PG8_LDA(dst, b, h) do { _Pragma("unroll") for (int m = 0; m < 4; ++m) _Pragma("unroll") for (int k = 0; k < 2; ++k) dst[m][k] = *(const PG8_LAS bf16x8*)(lds + PG8_SA(b, h) + aoff + m * 2048 + k * 1024); } while (0)
#define PG8_LDB(dst, b, h) do { _Pragma("unroll") for (int n = 0; n < 2; ++n) _Pragma("unroll") for (int k = 0; k < 2; ++k) dst[n][k] = *(const PG8_LAS bf16x8*)(lds + PG8_SB(b, h) + boff + n * 2048 + k * 1024); } while (0)
#define PG8_MMA(ai, bj, At, Bt) do { __builtin_amdgcn_s_setprio(1); _Pragma("unroll") for (int m = 0; m < 4; ++m) _Pragma("unroll") for (int n = 0; n < 2; ++n) _Pragma("unroll") for (int k = 0; k < 2; ++k) \
        acc[ai][bj][m][n] = __builtin_amdgcn_mfma_f32_16x16x32_bf16(Bt[n][k], At[m][k], acc[ai][bj][m][n], 0, 0, 0); __builtin_amdgcn_s_setprio(0); } while (0)
#define PG8_WAIT_V(n) asm volatile("s_waitcnt vmcnt(" #n ")" ::: "memory")
#define PG8_WAIT_L(n) asm volatile("s_waitcnt lgkmcnt(" #n ")" ::: "memory")
#define PG8_BAR __builtin_amdgcn_s_barrier()
#define PG8_SCHED __builtin_amdgcn_sched_barrier(0)
    Unit cur, nxt; int ui = 0;
    if (!S.next(0, cur)) return;
    f32x4 acc[2][2][4][2];
#pragma unroll
    for (int a = 0; a < 2; ++a)
#pragma unroll
        for (int b = 0; b < 2; ++b)
#pragma unroll
            for (int m = 0; m < 4; ++m)
#pragma unroll
                for (int n = 0; n < 2; ++n) acc[a][b][m][n] = (f32x4){0.f, 0.f, 0.f, 0.f};
    bf16x8 At[4][2], B0[2][2], B1[2][2];
    const char* cA = (const char*)g.A + (size_t)cur.pm * tstep; const char* cB = (const char*)g.Bt + (size_t)cur.pn * tstep;
    S.a_ready(cur);
    if constexpr (SP2) {
        PG8_STAGE(PG8_SB(0, 0), cB, voffB); PG8_STAGE(PG8_SB(0, 1), cB + hstep, voffB); PG8_STAGE(PG8_SA(0, 0), cA, voffA); PG8_STAGE(PG8_SA(0, 1), cA + hstep, voffA);
        if (wr == 1) PG8_BAR;
        PG8_WAIT_V(2); PG8_BAR;
        PG8_STAGE(PG8_SB(1, 0), cB + kstep, voffB); PG8_STAGE(PG8_SA(1, 0), cA + kstep, voffA); PG8_STAGE(PG8_SB(1, 1), cB + hstep + kstep, voffB);
        PG8_WAIT_V(6); PG8_BAR;
    } else {
        PG8_STAGE(PG8_SB(0, 0), cB, voffB); PG8_STAGE(PG8_SA(0, 0), cA, voffA); PG8_STAGE(PG8_SB(0, 1), cB + hstep, voffB); PG8_STAGE(PG8_SA(0, 1), cA + hstep, voffA);
        if (wr == 1) PG8_BAR;
        PG8_WAIT_V(4); PG8_BAR;
        PG8_STAGE(PG8_SB(1, 0), cB + kstep, voffB); PG8_STAGE(PG8_SA(1, 0), cA + kstep, voffA); PG8_STAGE(PG8_SB(1, 1), cB + hstep + kstep, voffB);
        PG8_WAIT_V(6); PG8_BAR;
    }
    for (;;) {
        const bool has_next = S.next(ui + 1, nxt);
        const char* nA = has_next ? (const char*)g.A + (size_t)nxt.pm * tstep : cA; const char* nB = has_next ? (const char*)g.Bt + (size_t)nxt.pn * tstep : cB;
        for (int t = 0; t < nt; t += 2) {
            const bool last = (t == nt - 2);
            const char* a1 = cA + (size_t)(t + 1) * kstep;
            const char* a2 = last ? nA : cA + (size_t)(t + 2) * kstep; const char* b2 = last ? nB : cB + (size_t)(t + 2) * kstep;
            const char* a3 = a2 + kstep; const char* b3 = b2 + kstep;
            if (last && has_next) S.a_ready(nxt);
            if constexpr (SP2) {
            PG8_LDB(B0, 0, 0); PG8_LDB(B1, 0, 1); PG8_SCHED; PG8_LDA(At, 0, 0); PG8_STAGE(PG8_SA(1, 1), a1 + hstep, voffA);
            PG8_WAIT_V(8); PG8_WAIT_L(0); PG8_BAR; PG8_MMA(0, 0, At, B0); PG8_MMA(0, 1, At, B1); PG8_BAR; PG8_SCHED;
            PG8_LDA(At, 0, 1); PG8_STAGE(PG8_SB(0, 0), b2, voffB); PG8_STAGE(PG8_SB(0, 1), b2 + hstep, voffB); PG8_STAGE(PG8_SA(0, 0), a2, voffA);
            PG8_WAIT_V(8); PG8_WAIT_L(0); PG8_BAR; PG8_MMA(1, 0, At, B0); PG8_MMA(1, 1, At, B1); PG8_BAR; PG8_SCHED;
            PG8_LDB(B0, 1, 0); PG8_LDB(B1, 1, 1); PG8_SCHED; PG8_LDA(At, 1, 0); PG8_STAGE(PG8_SA(0, 1), a2 + hstep, voffA);
            PG8_WAIT_V(8); PG8_WAIT_L(0); PG8_BAR; PG8_MMA(0, 0, At, B0); PG8_MMA(0, 1, At, B1); PG8_BAR; PG8_SCHED;
            PG8_LDA(At, 1, 1); PG8_STAGE(PG8_SB(1, 0), b3, voffB); PG8_STAGE(PG8_SB(1, 1), b3 + hstep, voffB); PG8_STAGE(PG8_SA(1, 0), a3, voffA);
            PG8_WAIT_V(8); PG8_WAIT_L(0); PG8_BAR; PG8_MMA(1, 0, At, B0); PG8_MMA(1, 1, At, B1); PG8_BAR; PG8_SCHED;
            } else {
            PG8_LDB(B0, 0, 0); PG8_SCHED; PG8_LDA(At, 0, 0); PG8_STAGE(PG8_SA(1, 1), a1 + hstep, voffA);
            PG8_WAIT_L(8); PG8_BAR; PG8_WAIT_L(0); PG8_MMA(0, 0, At, B0); PG8_BAR; PG8_SCHED;
            PG8_LDB(B1, 0, 1); PG8_STAGE(PG8_SB(0, 0), b2, voffB);
            PG8_BAR; PG8_WAIT_L(0); PG8_MMA(0, 1, At, B1); PG8_BAR;
            PG8_LDA(At, 0, 1); PG8_STAGE(PG8_SA(0, 0), a2, voffA);
            PG8_BAR; PG8_WAIT_L(0); PG8_MMA(1, 0, At, B0); PG8_BAR; PG8_SCHED;
            PG8_STAGE(PG8_SB(0, 1), b2 + hstep, voffB);
            PG8_WAIT_V(6); PG8_BAR; PG8_MMA(1, 1, At, B1); PG8_BAR;
            PG8_LDB(B0, 1, 0); PG8_SCHED; PG8_LDA(At, 1, 0); PG8_STAGE(PG8_SA(0, 1), a2 + hstep, voffA);
            PG8_WAIT_L(8); PG8_BAR; PG8_WAIT_L(0); PG8_MMA(0, 0, At, B0); PG8_BAR; PG8_SCHED;
            PG8_LDB(B1, 1, 1); PG8_STAGE(PG8_SB(1, 0), b3, voffB);
            PG8_BAR; PG8_WAIT_L(0); PG8_MMA(0, 1, At, B1); PG8_BAR;
            PG8_LDA(At, 1, 1); PG8_STAGE(PG8_SA(1, 0), a3, voffA);
            PG8_BAR; PG8_WAIT_L(0); PG8_MMA(1, 0, At, B0); PG8_BAR; PG8_SCHED;
            PG8_STAGE(PG8_SB(1, 1), b3 + hstep, voffB);
            PG8_WAIT_V(6); PG8_BAR; PG8_MMA(1, 1, At, B1); PG8_BAR;
            }
        }
        if constexpr (ALIGN_EPI) { if (wr == 0) PG8_BAR; }
        if constexpr (!Epi::AFTER_DRAIN) { E(acc, cur, wr, wc, fr, fq); S.done(cur); }
        if (!has_next) break;
#pragma unroll
        for (int a = 0; a < 2; ++a)
#pragma unroll
            for (int b = 0; b < 2; ++b)
#pragma unroll
                for (int m = 0; m < 4; ++m)
#pragma unroll
                    for (int n = 0; n < 2; ++n) acc[a][b][m][n] = (f32x4){0.f, 0.f, 0.f, 0.f};
        cur = nxt; cA = nA; cB = nB; ++ui;
        if constexpr (ALIGN_EPI) { if (wr == 1) PG8_BAR; }
    }
    PG8_WAIT_V(0);
    if constexpr (!ALIGN_EPI) { if (wr == 0) PG8_BAR; }
    PG8_BAR;
#undef PG8_SA
#undef PG8_SB
#undef PG8_STAGE
#undef PG8_LDA
#undef PG8_LDB
#undef PG8_MMA
#undef PG8_WAIT_V
#undef PG8_WAIT_L
#undef PG8_BAR
#undef PG8_SCHED
}
}

namespace att {
constexpr int NW = 8, QBLK = 32, KVBLK = 64, LDO = 2048;
constexpr size_t SHM_V = KVBLK * 128 * 2, SHM_K = KVBLK * 128 * 2, SHM_KR = KVBLK * 64 * 2;
constexpr size_t OFF_K = 2 * SHM_V, OFF_KR = OFF_K + 2 * SHM_K, OFF_WS = OFF_KR + 2 * SHM_KR, OFF_QR = OFF_WS + NW * 64 * 4, SHM_ATTN = OFF_QR + NW * 4 * 64 * 16;
#define KSWZ(row, colB) ((row) * 256 + ((colB) ^ (((row) & 7) << 4)))
#define KRSWZ(row, colB) ((row) * 128 + ((colB) ^ (((row) & 7) << 4)))
#define SBAR() __builtin_amdgcn_sched_barrier(0)
__device__ __forceinline__ int crow(int r, int hi) { return (r & 3) + 8 * (r >> 2) + 4 * hi; }
__device__ __forceinline__ unsigned cvtpk(float lo, float hi) { unsigned r; asm volatile("v_cvt_pk_bf16_f32 %0, %1, %2" : "=v"(r) : "v"(lo), "v"(hi)); return r; }
constexpr float THR = 8.f;

template <int DQK> struct Sc { static constexpr float SCALE = DQK == 128 ? 0.088388347648318440f : 0.072168783648703220f; };

template <int DQK> __device__ __forceinline__ void partialSM(f32x16& p0, f32x16& p1, float& m_reg, float& mn, float& alpha) {
  constexpr float SCALE = Sc<DQK>::SCALE; constexpr float C = SCALE * 1.4426950408889634f;
  float pmax = p0[0];
#pragma unroll
  for (int r = 1; r < 16; ++r) pmax = fmaxf(pmax, p0[r]);
#pragma unroll
  for (int r = 0; r < 16; ++r) pmax = fmaxf(pmax, p1[r]);
  { auto rr = __builtin_amdgcn_permlane32_swap(__float_as_uint(pmax), __float_as_uint(pmax), false, false);
    pmax = fmaxf(__uint_as_float(rr[0]), __uint_as_float(rr[1])); }
  if (__builtin_expect(__all(pmax - m_reg <= THR / SCALE), 1)) { mn = m_reg; alpha = 1.f; }
  else { mn = fmaxf(m_reg, pmax); alpha = __builtin_amdgcn_exp2f((m_reg - mn) * C); m_reg = mn; }
  float mnC = -mn * C;
#pragma unroll
  for (int r = 0; r < 16; ++r) p0[r] = fmaf(p0[r], C, mnC);
#pragma unroll
  for (int r = 0; r < 16; ++r) p1[r] = fmaf(p1[r], C, mnC);
#pragma unroll
  for (int r = 0; r < 16; ++r) p0[r] = __builtin_amdgcn_exp2f(p0[r]);
}
__device__ __forceinline__ void finishSM(f32x16& p0, f32x16& p1, float alpha, float& l_reg, bf16x8& pa0, bf16x8& pa1, bf16x8& pa2, bf16x8& pa3) {
#pragma unroll
  for (int r = 0; r < 16; ++r) p1[r] = __builtin_amdgcn_exp2f(p1[r]);
  float ps = 0;
#pragma unroll
  for (int r = 0; r < 16; ++r) ps += p0[r];
#pragma unroll
  for (int r = 0; r < 16; ++r) ps += p1[r];
  { auto rr = __builtin_amdgcn_permlane32_swap(__float_as_uint(ps), __float_as_uint(ps), false, false);
    ps = __uint_as_float(rr[0]) + __uint_as_float(rr[1]); }
  l_reg = l_reg * alpha + ps;
#define PK4(P, BASE, OUT) do { unsigned a0 = cvtpk(P[BASE + 0], P[BASE + 1]), a1 = cvtpk(P[BASE + 2], P[BASE + 3]);   \
    unsigned b0 = cvtpk(P[BASE + 4], P[BASE + 5]), b1 = cvtpk(P[BASE + 6], P[BASE + 7]);                              \
    auto r0 = __builtin_amdgcn_permlane32_swap(a0, b0, false, false); auto r1 = __builtin_amdgcn_permlane32_swap(a1, b1, false, false); \
    u32x4 w = {r0[0], r1[0], r0[1], r1[1]}; OUT = *reinterpret_cast<bf16x8*>(&w); } while (0)
  PK4(p0, 0, pa0); PK4(p0, 8, pa1); PK4(p1, 0, pa2); PK4(p1, 8, pa3);
#undef PK4
}
template <int DQK> __device__ __forceinline__ void qkt(f32x16& p0, f32x16& p1, const char* Ks, const char* Krs, const bf16x8* qr, const char* qrl, int r32, int hi) {
  p0 = f32x16{}; p1 = f32x16{};
#pragma unroll
  for (int d0 = 0; d0 < 8; ++d0) { int cb = (d0 * 16 + hi * 8) * 2;
    bf16x8 b0 = *reinterpret_cast<const bf16x8*>(Ks + KSWZ(r32, cb));
    bf16x8 b1 = *reinterpret_cast<const bf16x8*>(Ks + KSWZ(32 + r32, cb));
    p0 = __builtin_amdgcn_mfma_f32_32x32x16_bf16(b0, qr[d0], p0, 0, 0, 0);
    p1 = __builtin_amdgcn_mfma_f32_32x32x16_bf16(b1, qr[d0], p1, 0, 0, 0); }
  if constexpr (DQK == 192) {
#pragma unroll
    for (int d0 = 0; d0 < 4; ++d0) { int cb = (d0 * 16 + hi * 8) * 2;
      bf16x8 b0 = *reinterpret_cast<const bf16x8*>(Krs + KRSWZ(r32, cb));
      bf16x8 b1 = *reinterpret_cast<const bf16x8*>(Krs + KRSWZ(32 + r32, cb));
      const bf16x8 qf = *reinterpret_cast<const bf16x8*>(qrl + d0 * 1024);
      p0 = __builtin_amdgcn_mfma_f32_32x32x16_bf16(b0, qf, p0, 0, 0, 0);
      p1 = __builtin_amdgcn_mfma_f32_32x32x16_bf16(b1, qf, p1, 0, 0, 0); }
  }
}
__device__ __forceinline__ int v_st(int k, int c) { const int kk = (k & ~0xC) | ((k & 4) << 1) | ((k & 8) >> 1); return ((kk >> 3) * 4 + (c >> 5)) * 512 + ((kk & 7) * 32 + (c & 31)) * 2; }
__device__ __forceinline__ int v_rd_base(int lane) { return ((lane & 3) << 3) | (((lane >> 2) & 3) << 6) | (((lane >> 4) & 1) << 5) | (((lane >> 5) & 1) << 8); }
constexpr int v_rd_off(int d0, int ks, int half) { return d0 * 512 + ks * 4096 + half * 2048; }
template <int OFF> __device__ __forceinline__ s16x4 tr_read(int vb) {
  s16x4 r; asm volatile("ds_read_b64_tr_b16 %0, %1 offset:%2" : "=&v"(r) : "v"(vb), "i"(OFF) : "memory"); return r;
}
template <int D0> __device__ __forceinline__ void pv_one(f32x16& od, int vb, bf16x8 pa0, bf16x8 pa1, bf16x8 pa2, bf16x8 pa3) {
  const s16x4 l0 = tr_read<v_rd_off(D0, 0, 0)>(vb), h0 = tr_read<v_rd_off(D0, 0, 1)>(vb), l1 = tr_read<v_rd_off(D0, 1, 0)>(vb), h1 = tr_read<v_rd_off(D0, 1, 1)>(vb);
  const s16x4 l2 = tr_read<v_rd_off(D0, 2, 0)>(vb), h2 = tr_read<v_rd_off(D0, 2, 1)>(vb), l3 = tr_read<v_rd_off(D0, 3, 0)>(vb), h3 = tr_read<v_rd_off(D0, 3, 1)>(vb);
  asm volatile("s_waitcnt lgkmcnt(0)" ::: "memory"); SBAR();
#define PK(L, H) (bf16x8){L[0], L[1], L[2], L[3], H[0], H[1], H[2], H[3]}
  od = __builtin_amdgcn_mfma_f32_32x32x16_bf16(pa0, PK(l0, h0), od, 0, 0, 0);
  od = __builtin_amdgcn_mfma_f32_32x32x16_bf16(pa1, PK(l1, h1), od, 0, 0, 0);
  od = __builtin_amdgcn_mfma_f32_32x32x16_bf16(pa2, PK(l2, h2), od, 0, 0, 0);
  od = __builtin_amdgcn_mfma_f32_32x32x16_bf16(pa3, PK(l3, h3), od, 0, 0, 0);
#undef PK
}
__device__ __forceinline__ void pv_d0(f32x16* o, int vb, bf16x8 pa0, bf16x8 pa1, bf16x8 pa2, bf16x8 pa3) {
  pv_one<0>(o[0], vb, pa0, pa1, pa2, pa3); pv_one<1>(o[1], vb, pa0, pa1, pa2, pa3); pv_one<2>(o[2], vb, pa0, pa1, pa2, pa3); pv_one<3>(o[3], vb, pa0, pa1, pa2, pa3);
}

template <int DQK, int LDQ, int LDK, int LDV>
__device__ __forceinline__ void attn_body(const bf16_t* __restrict__ Qb, const bf16_t* __restrict__ Kh, const bf16_t* __restrict__ Vh,
                                          bf16_t* __restrict__ Ob, int seq, char* lds, const int tid) {
  constexpr int NQ = 8; constexpr int SD = DQK == 192 ? 1 : 2;
  const int wid = tid >> 6, lane = tid & 63, r32 = lane & 31, hi = lane >> 5;
  char* V_lds = lds; char* K_lds = lds + OFF_K; char* KR_lds = lds + OFF_KR;
  float* ws = (float*)(lds + OFF_WS) + wid * 64; float* li_l = ws; float* al_l = ws + 32;
  float m_reg = -1e30f, l_reg = 0; f32x16 o[4] = {}; bf16x8 qr[NQ];
  const bf16_t* Qw = Qb + (long)(wid * QBLK + r32) * LDQ + hi * 8;
#pragma unroll
  for (int d0 = 0; d0 < NQ; ++d0) qr[d0] = *reinterpret_cast<const bf16x8*>(Qw + d0 * 16);
  char* qrl = lds + OFF_QR + wid * 4096 + lane * 16;
  if constexpr (DQK == 192) {
#pragma unroll
    for (int d0 = 0; d0 < 4; ++d0) *reinterpret_cast<bf16x8*>(qrl + d0 * 1024) = *reinterpret_cast<const bf16x8*>(Qw + 128 + d0 * 16);
  }
  const int sr = tid >> 4, sc = (tid & 15) * 8, vst0 = v_st(sr, sc), vst1 = v_st(32 + sr, sc);
  const int rr_ = tid >> 3, rc_ = (tid & 7) * 8;
  const int vb0 = (int)(uintptr_t)V_lds + v_rd_base(lane);
  struct { bf16x8 vs0, vs1, ks0, ks1, kr; } sr_[SD];
  const unsigned voffV = (unsigned)(sr * LDV + sc) * 2u, voffK = (unsigned)(sr * LDK + sc) * 2u, voffR = (unsigned)(rr_ * LDK + 128 + rc_) * 2u;
#define SLOAD(i, k0) do { const char* vb_ = (const char*)(Vh + (size_t)(k0) * LDV); const char* kb_ = (const char*)(Kh + (size_t)(k0) * LDK); \
    sr_[i].vs0 = *(const bf16x8*)(vb_ + voffV); sr_[i].vs1 = *(const bf16x8*)(vb_ + 32 * LDV * 2 + voffV); \
    sr_[i].ks0 = *(const bf16x8*)(kb_ + voffK); sr_[i].ks1 = *(const bf16x8*)(kb_ + 32 * LDK * 2 + voffK); \
    if constexpr (DQK == 192) sr_[i].kr = *(const bf16x8*)(kb_ + voffR); } while (0)
#define SWRITE(b, i) do { *(bf16x8*)(V_lds + (b) * SHM_V + vst0) = sr_[i].vs0;          \
    *(bf16x8*)(V_lds + (b) * SHM_V + vst1) = sr_[i].vs1; int kc = sc * 2;               \
    *(bf16x8*)(K_lds + (b) * SHM_K + KSWZ(sr, kc)) = sr_[i].ks0;                       \
    *(bf16x8*)(K_lds + (b) * SHM_K + KSWZ(32 + sr, kc)) = sr_[i].ks1;                  \
    if constexpr (DQK == 192) *(bf16x8*)(KR_lds + (b) * SHM_KR + KRSWZ(rr_, rc_ * 2)) = sr_[i].kr; } while (0)
#define SWAIT() do { if constexpr (SD == 1) asm volatile("s_waitcnt vmcnt(0)" ::: "memory"); else asm volatile("s_waitcnt vmcnt(4)" ::: "memory"); } while (0)
#define RESC(a) do { if (__any((a) < 1.f)) { if (hi == 0) al_l[r32] = (a); asm volatile("s_waitcnt lgkmcnt(0)" ::: "memory"); \
    _Pragma("unroll") for (int d = 0; d < 4; ++d) _Pragma("unroll") for (int r = 0; r < 16; ++r) o[d][r] *= al_l[crow(r, hi)]; } } while (0)
  f32x16 pA0, pA1, pB0, pB1; float mnA, mnB, alA, alB; bf16x8 pa0, pa1, pa2, pa3; const int NT = seq / KVBLK;
  constexpr int SE = 0, SO = SD - 1;
  SLOAD(SE, 0); asm volatile("s_waitcnt vmcnt(0)" ::: "memory"); SWRITE(0, SE); __syncthreads();
  qkt<DQK>(pA0, pA1, K_lds, KR_lds, qr, qrl, r32, hi); partialSM<DQK>(pA0, pA1, m_reg, mnA, alA);
  SLOAD(SO, KVBLK); if constexpr (SD == 2) { if (2 < NT) SLOAD(SE, 2 * KVBLK); }
  SWAIT(); SWRITE(1, SO); __syncthreads();
  for (int j = 1; j + 1 < NT; j += 2) {
    SBAR(); qkt<DQK>(pB0, pB1, K_lds + SHM_K, KR_lds + SHM_KR, qr, qrl, r32, hi);
    finishSM(pA0, pA1, alA, l_reg, pa0, pa1, pa2, pa3); SBAR();
    SLOAD(SO, (j + SD) * KVBLK); SBAR();
    pv_d0(o, vb0, pa0, pa1, pa2, pa3); partialSM<DQK>(pB0, pB1, m_reg, mnB, alB);
    __syncthreads(); SWAIT(); SWRITE(0, SE);
    RESC(alB); __syncthreads();
    SBAR(); qkt<DQK>(pA0, pA1, K_lds, KR_lds, qr, qrl, r32, hi);
    finishSM(pB0, pB1, alB, l_reg, pa0, pa1, pa2, pa3); SBAR();
    if (SD == 1 || j + 3 < NT) SLOAD(SE, (j + 1 + SD) * KVBLK); SBAR();
    pv_d0(o, vb0 + (int)SHM_V, pa0, pa1, pa2, pa3); partialSM<DQK>(pA0, pA1, m_reg, mnA, alA);
    __syncthreads(); SWAIT(); SWRITE(1, SO);
    RESC(alA); __syncthreads();
  }
  SBAR(); qkt<DQK>(pB0, pB1, K_lds + SHM_K, KR_lds + SHM_KR, qr, qrl, r32, hi);
  finishSM(pA0, pA1, alA, l_reg, pa0, pa1, pa2, pa3); SBAR();
  pv_d0(o, vb0, pa0, pa1, pa2, pa3); partialSM<DQK>(pB0, pB1, m_reg, mnB, alB);
  __syncthreads(); RESC(alB);
  finishSM(pB0, pB1, alB, l_reg, pa0, pa1, pa2, pa3); SBAR();
  pv_d0(o, vb0 + (int)SHM_V, pa0, pa1, pa2, pa3);
  LAS unsigned char* ldsl = (LAS unsigned char*)lds;
  LAS float* li3 = (LAS float*)(ldsl + OFF_WS) + wid * 64;
  if (hi == 0) li3[r32] = l_reg; asm volatile("s_waitcnt lgkmcnt(0)" ::: "memory");
  float rli[16];
#pragma unroll
  for (int r = 0; r < 16; ++r) rli[r] = __builtin_amdgcn_rcpf(li3[crow(r, hi)]);
  __syncthreads();
  { LAS bf16_t* stg = (LAS bf16_t*)(ldsl + wid * 8192);
#pragma unroll
    for (int r = 0; r < 16; ++r) { const int orow = crow(r, hi);
#pragma unroll
      for (int d0 = 0; d0 < 4; ++d0) stg[orow * 128 + d0 * 32 + r32] = (bf16_t)f2bf(o[d0][r] * rli[r]); }
    asm volatile("s_waitcnt lgkmcnt(0)" ::: "memory");
    bf16_t* Obl = Ob; asm volatile("" : "+s"(Obl));
    int lane_l = lane; asm volatile("" : "+v"(lane_l));
    bf16_t* Ow = Obl + (long)(wid * QBLK + (lane_l >> 4)) * LDO + (lane_l & 15) * 8;
    const LAS bf16_t* sp = stg + (lane_l >> 4) * 128 + (lane_l & 15) * 8;
#pragma unroll 1
    for (int i = 0; i < 8; ++i) { const u32x4 v = *(const LAS u32x4*)(sp + i * 512); *(u32x4*)Ow = v; Ow += 4 * LDO; } }
  __syncthreads();
#undef SLOAD
#undef SWRITE
#undef SWAIT
#undef RESC
}
}

constexpr int NWAVES = 8, NTHR = 512;
constexpr int LDS_BYTES = 131072 + 1024;

struct Ctx {
    int tid, lane, wave, G, gw, NGW, bx;
    int xp, xn, xr, vc;
};

__device__ __forceinline__ void p0_transpose_item(const float* W, int K, int N, bf16_t* WT, int k0, int n0, int drow0, LAS float* scr, int lane) {
#pragma unroll 8
    for (int i = 0; i < 32; ++i) { const int kk = 2 * i + (lane >> 5); scr[kk * 33 + (lane & 31)] = W[(size_t)(k0 + kk) * N + n0 + (lane & 31)]; }
    asm volatile("s_waitcnt lgkmcnt(0)" ::: "memory");
    const int c = lane & 7;
#pragma unroll
    for (int j = 0; j < 4; ++j) { const int n = (lane >> 3) + 8 * j; const LAS float* s = scr + (8 * c) * 33 + n;
        u32x4 o; o.x = pk2(s[0 * 33], s[1 * 33]); o.y = pk2(s[2 * 33], s[3 * 33]); o.z = pk2(s[4 * 33], s[5 * 33]); o.w = pk2(s[6 * 33], s[7 * 33]);
        *(u32x4*)(WT + (size_t)(drow0 + n) * K + k0 + 8 * c) = o; }
    asm volatile("s_waitcnt lgkmcnt(0)" ::: "memory");
}

__device__ __forceinline__ void phase0(AP a, const Ctx& c, LAS unsigned char* lds) {
    LAS float* sil = (LAS float*)lds;
    for (int i = c.tid; i < 9 * 2048; i += NTHR) { const int s = i >> 11, k = i & 2047; const float v = s == 0 ? a->in[8][k] : a->in[7][(s - 1) * 2048 + k]; sil[i] = v / (1.f + __expf(-v)); }
    __syncthreads();
    float* mod = (float*)(a->ws + WS_MOD);
    LAS float* red = (LAS float*)(lds + 73728);
    for (int it = c.bx; it < 2 * 96; it += c.G) {
        const int l = it / 96, cb = it % 96; const int col = cb * 128 + c.lane * 2;
        const float* wp = a->in[9] + ((size_t)l * 2048 + c.wave * 256) * 12288 + col;
        f32x2 acc[9];
#pragma unroll
        for (int s = 0; s < 9; ++s) acc[s] = (f32x2){0.f, 0.f};
#pragma unroll 8
        for (int k = 0; k < 256; ++k) { const f32x2 w = *(const f32x2*)(wp + (size_t)k * 12288);
#pragma unroll
            for (int s = 0; s < 9; ++s) acc[s] += w * sil[s * 2048 + c.wave * 256 + k]; }
#pragma unroll
        for (int s = 0; s < 9; ++s) *(LAS f32x2*)(red + (c.wave * 9 + s) * 128 + c.lane * 2) = acc[s];
        __syncthreads();
        for (int idx = c.tid; idx < 9 * 128; idx += NTHR) { const int s = idx >> 7, cc = idx & 127; float v = a->in[10][(size_t)l * 12288 + cb * 128 + cc];
#pragma unroll
            for (int w = 0; w < 8; ++w) v += red[(w * 9 + s) * 128 + cc];
            mod[((size_t)l * 9 + s) * 12288 + cb * 128 + cc] = v; }
        __syncthreads();
    }
    __syncthreads();
    LAS float* scr = (LAS float*)(lds + c.wave * 8448);
    constexpr int I_IN = 32 * 110, I_OUT = 32 * 64, I_F1 = 32 * 256, I_F2 = 128 * 64, I_GLU = 8 * 32, I_UK = 8 * 24;
    constexpr int I_L = I_IN + I_OUT + I_F1 + I_F2 + I_GLU + 2 * I_UK;
    for (int it = c.gw; it < 2 * I_L; it += c.NGW) {
        const int l = it / I_L; int r = it % I_L;
        unsigned char* wl = a->ws + WS_W + (size_t)l * WL_SIZE;
        const float* W; int K, N; bf16_t* WT; int mode = 0, roff = 0;
        if (r < I_IN) { W = a->in[13] + (size_t)l * 2048 * INW; K = 2048; N = INW; WT = (bf16_t*)(wl + WL_IN); }
        else if ((r -= I_IN) < I_OUT) { W = a->in[30] + (size_t)l * 2048 * 2048; K = 2048; N = 2048; WT = (bf16_t*)(wl + WL_OUT); }
        else if ((r -= I_OUT) < I_F1) { W = a->in[31] + (size_t)l * 2048 * 8192; K = 2048; N = 8192; WT = (bf16_t*)(wl + WL_FF1); }
        else if ((r -= I_F1) < I_F2) { W = a->in[32] + (size_t)l * 8192 * 2048; K = 8192; N = 2048; WT = (bf16_t*)(wl + WL_FF2); }
        else if ((r -= I_F2) < I_GLU) { W = a->in[29] + (size_t)l * 512 * 1024; K = 512; N = 1024; WT = (bf16_t*)(wl + WL_GLU); mode = 1; }
        else if ((r -= I_GLU) < I_UK) { W = a->in[19] + (size_t)l * 512 * 768; K = 512; N = 768; WT = (bf16_t*)(wl + WL_UKV); }
        else { r -= I_UK; W = a->in[20] + (size_t)l * 512 * 768; K = 512; N = 768; WT = (bf16_t*)(wl + WL_UKV); roff = 768; }
        const int nblk = N / 32, kb = r / nblk, nb = r % nblk, k0 = 64 * kb, n0 = 32 * nb;
        int drow0 = n0 + roff;
        if (mode == 1) { drow0 = n0 < 512 ? 256 * (n0 >> 7) + (n0 & 127) : 256 * ((n0 - 512) >> 7) + 128 + ((n0 - 512) & 127); }
        p0_transpose_item(W, K, N, WT, k0, n0, drow0, scr, c.lane);
    }
    for (int i = c.gw * 64 + c.lane; i < 2 * 64 * 256; i += c.NGW * 64) { const int l = i / (64 * 256), q = i % (64 * 256);
        bf16_t* WT = (bf16_t*)(a->ws + WS_W + (size_t)l * WL_SIZE + WL_IN) + (size_t)INW * 2048;
        *(u32x4*)(WT + (size_t)q * 8) = (u32x4){0u, 0u, 0u, 0u}; }
}

__device__ __forceinline__ void phase_norm(AP a, const Ctx& c, int l, int which  , bool x_from_in) {
    const float* gw = a->in[which ? 12 : 11] + (size_t)l * DM;
    const float* modl = (const float*)(a->ws + WS_MOD) + (size_t)l * 9 * 12288;
    bf16_t* HN = (bf16_t*)(a->ws + WS_HN);
    auto xptr = [&](int r) { return x_from_in ? (r < NCTXR ? a->in[0] + (size_t)r * DM : a->in[1] + (size_t)(r - NCTXR) * DM) : a->out + (size_t)r * DM; };
    f32x4 vn[8];
    if (c.gw < NTOK) { const f32x4* xr = (const f32x4*)xptr(c.gw) + c.lane;
#pragma unroll
        for (int j = 0; j < 8; ++j) vn[j] = xr[64 * j]; }
    for (int r = c.gw; r < NTOK; r += c.NGW) {
        const int set = r < NCTXR ? 0 : 1 + ((r - NCTXR) >> 10);
        const float* shp = modl + (size_t)set * 12288 + (which ? 3 * DM : 0); const float* scp = shp + DM;
        f32x4 v[8]; float s = 0.f;
#pragma unroll
        for (int j = 0; j < 8; ++j) { v[j] = vn[j]; s += (v[j].x * v[j].x + v[j].y * v[j].y) + (v[j].z * v[j].z + v[j].w * v[j].w); }
        f32x4 gg[8], sc[8], sh[8];
#pragma unroll
        for (int j = 0; j < 8; ++j) { gg[j] = ((const f32x4*)gw)[c.lane + 64 * j]; sc[j] = ((const f32x4*)scp)[c.lane + 64 * j]; sh[j] = ((const f32x4*)shp)[c.lane + 64 * j]; }
        if (r + c.NGW < NTOK) { const f32x4* xr = (const f32x4*)xptr(r + c.NGW) + c.lane;
#pragma unroll
            for (int j = 0; j < 8; ++j) vn[j] = xr[64 * j]; }
        asm volatile("" ::: "memory");
        const float rstd = rsqrtf(wave_sum(s) * (1.f / DM) + EPSN);
        u32x2* o8 = (u32x2*)(HN + (size_t)r * DM) + c.lane;
#pragma unroll
        for (int j = 0; j < 8; ++j) { const f32x4 y = v[j] * rstd * gg[j] * (sc[j] + 1.f) + sh[j]; u32x2 w; w.x = pk2(y.x, y.y); w.y = pk2(y.z, y.w); o8[64 * j] = w; }
    }
}

constexpr float L2_10000 = 13.287712379549449f;
__device__ __forceinline__ float swz16(float v) { return __builtin_bit_cast(float, __builtin_amdgcn_ds_swizzle(__builtin_bit_cast(int, v), 0x401F)); }
__device__ __forceinline__ float swz8(float v) { return __builtin_bit_cast(float, __builtin_amdgcn_ds_swizzle(__builtin_bit_cast(int, v), 0x201F)); }
__device__ __forceinline__ float lo_bf(unsigned w) { return __builtin_bit_cast(float, w << 16); }
__device__ __forceinline__ float hi_bf(unsigned w) { return __builtin_bit_cast(float, w & 0xffff0000u); }
__device__ __forceinline__ float rowsum16(float v) { v += dpp_f(v, 0); v += dpp_f(v, 1); v += dpp_f(v, 2); v += dpp_f(v, 3); return v; }
__device__ __forceinline__ float rlf(float v, int lane_) { return __builtin_bit_cast(float, __builtin_amdgcn_readlane(__builtin_bit_cast(int, v), lane_)); }
__device__ __forceinline__ float ror8(float v) { return __builtin_bit_cast(float, __builtin_amdgcn_mov_dpp(__builtin_bit_cast(int, v), 0x128, 0xF, 0xF, true)); }
__device__ __forceinline__ float swz4(float v) { return __builtin_bit_cast(float, __builtin_amdgcn_ds_swizzle(__builtin_bit_cast(int, v), 0x101F)); }
__device__ __forceinline__ void zpost_rows(AP a, const Ctx& c, int l) {
    const bf16_t* Z = (const bf16_t*)(a->ws + WS_Z);
    bf16_t* QB = (bf16_t*)(a->ws + WS_QB); bf16_t* KB = (bf16_t*)(a->ws + WS_KB); bf16_t* VB = (bf16_t*)(a->ws + WS_VB);
    bf16_t* QC = (bf16_t*)(a->ws + WS_QC); bf16_t* CKVN = (bf16_t*)(a->ws + WS_CKVN); float* KR = (float*)(a->ws + WS_KR);
    const int lane = c.lane;
    const int hp = lane >> 5, m = lane & 31;
    const int halfg = m >> 4; const bool isx1 = (m & 8) == 0; const int ig = 4 * (m & 7);
    float invg[4], invc[4];
#pragma unroll
    for (int e = 0; e < 4; ++e) invg[e] = __builtin_amdgcn_exp2f(-(float)(ig + e) * (L2_10000 / 32.f));
    const f32x4 gq4 = *(const f32x4*)(a->in[14] + l * 128 + 4 * m), gk4 = *(const f32x4*)(a->in[15] + l * 128 + 4 * m);
    const int mt = lane & 15, ht = lane >> 4;
    const int halfc = mt >> 3; const bool isx1c = (mt & 4) == 0; const int ic = 4 * (mt & 3);
#pragma unroll
    for (int e = 0; e < 4; ++e) invc[e] = __builtin_amdgcn_exp2f(-(float)(ic + e) * (L2_10000 / 16.f));
    const f32x4 gcn4 = *(const f32x4*)(a->in[17] + l * 192 + 4 * m), gcr4 = *(const f32x4*)(a->in[17] + l * 192 + 128 + 4 * mt);
    const f32x4 gkv0 = *(const f32x4*)(a->in[16] + l * 512 + lane * 8), gkv1 = *(const f32x4*)(a->in[16] + l * 512 + lane * 8 + 4);
    const bool zsplit = c.G * NWAVES > 512 + 64;
    if (zsplit && c.wave < 2) return;
    const int zgw = zsplit ? c.bx * 6 + (c.wave - 2) : c.gw, zn = zsplit ? c.G * 6 : c.NGW;
    for (int r = zgw; r < NTOK + 4096; r += zn) {
        if (r >= NTOK) {
            const int q = r - NTOK, b = q >> 9, t = q & 511; const size_t kvrow = 8192 + (size_t)b * 1536 + t; const size_t crow_ = ((size_t)(b * 2 + l) * 512 + t);
            const f32x4 kk = *(const f32x4*)(a->in[2] + crow_ * 256 + lane * 4), vv = *(const f32x4*)(a->in[3] + crow_ * 256 + lane * 4);
            const f32x4 c0 = *(const f32x4*)(a->in[4] + crow_ * 512 + lane * 8), c1 = *(const f32x4*)(a->in[4] + crow_ * 512 + lane * 8 + 4);
            const float krv = a->in[5][crow_ * 64 + lane];
            u32x2 w; w.x = pk2(kk.x, kk.y); w.y = pk2(kk.z, kk.w); *(u32x2*)(KB + kvrow * 256 + lane * 4) = w;
            w.x = pk2(vv.x, vv.y); w.y = pk2(vv.z, vv.w); *(u32x2*)(VB + kvrow * 256 + lane * 4) = w;
            u32x4 w4; w4.x = pk2(c0.x, c0.y); w4.y = pk2(c0.z, c0.w); w4.z = pk2(c1.x, c1.y); w4.w = pk2(c1.z, c1.w); *(u32x4*)(CKVN + kvrow * 512 + lane * 8) = w4;
            KR[kvrow * 64 + lane] = krv;
            continue;
        }
        const bf16_t* z = Z + (size_t)r * INWP;
        const bool lat = r >= NCTXR;
        int b, t; size_t kvrow;
        if (!lat) { b = r >> 8; t = r & 255; kvrow = r; } else { const int q = r - NCTXR; b = q >> 10; t = q & 1023; kvrow = 8192 + (size_t)b * 1536 + 512 + t; }
        const size_t orow = ((size_t)(b * 2 + l) * 256 + t);
        u32x2 zq[3], zc[3], zk, zv, zra, zrb = (u32x2){0u, 0u}, zkr = (u32x2){0u, 0u};
#pragma unroll
        for (int j = 0; j < 3; ++j) { zq[j] = *(const u32x2*)(z + ZQB + 256 * j + 4 * lane); zc[j] = *(const u32x2*)(z + ZQC + 192 * (2 * j + hp) + 4 * m); }
        zk = *(const u32x2*)(z + ZKB + 4 * lane); zv = *(const u32x2*)(z + ZVB + 4 * lane);
        zra = *(const u32x2*)(z + ZQC + 192 * ht + 128 + 4 * mt);
        if (lane < 32) zrb = *(const u32x2*)(z + ZQC + 192 * (4 + ht) + 128 + 4 * mt);
        const u32x4 raw = *(const u32x4*)(z + ZCKV + lane * 8);
        if (lane < 16) zkr = *(const u32x2*)(z + ZKR + 4 * lane);
        asm volatile("" ::: "memory");
        float cg[4], sg[4], cc[4], sc[4];
#pragma unroll
        for (int e = 0; e < 4; ++e) { cg[e] = 1.f; sg[e] = 0.f; cc[e] = 1.f; sc[e] = 0.f; }
        if (lat) { const float pg = halfg ? (float)(t & 63) : (float)(t >> 6), pc = halfc ? (float)(t & 63) : (float)(t >> 6);
#pragma unroll
            for (int e = 0; e < 4; ++e) { cg[e] = __cosf(pg * invg[e]); sg[e] = __sinf(pg * invg[e]); cc[e] = __cosf(pc * invc[e]); sc[e] = __sinf(pc * invc[e]); } }
#pragma unroll
        for (int e = 0; e < 4; ++e) { if (!isx1) sg[e] = -sg[e]; if (!isx1c) sc[e] = -sc[e]; }
#pragma unroll
        for (int j = 0; j < 3; ++j) { float v[4] = {lo_bf(zq[j].x), hi_bf(zq[j].x), lo_bf(zq[j].y), hi_bf(zq[j].y)};
            const float rs_ = rowsum16((v[0] * v[0] + v[1] * v[1]) + (v[2] * v[2] + v[3] * v[3]));
            const float sa = rlf(rs_, 0) + rlf(rs_, 16), sb = rlf(rs_, 32) + rlf(rs_, 48);
            const float rs = rsqrtf((hp ? sb : sa) * (1.f / 128.f) + EPSN);
            float n[4], o[4];
#pragma unroll
            for (int e = 0; e < 4; ++e) n[e] = v[e] * rs * gq4[e];
#pragma unroll
            for (int e = 0; e < 4; ++e) o[e] = n[e] * cg[e] - ror8(n[e]) * sg[e];
            u32x2 w; w.x = pk2(o[0], o[1]); w.y = pk2(o[2], o[3]); *(u32x2*)(QB + (size_t)r * 768 + 256 * j + 4 * lane) = w; }
        { float v[4] = {lo_bf(zk.x), hi_bf(zk.x), lo_bf(zk.y), hi_bf(zk.y)};
            const float rs_ = rowsum16((v[0] * v[0] + v[1] * v[1]) + (v[2] * v[2] + v[3] * v[3]));
            const float sa = rlf(rs_, 0) + rlf(rs_, 16), sb = rlf(rs_, 32) + rlf(rs_, 48);
            const float rs = rsqrtf((hp ? sb : sa) * (1.f / 128.f) + EPSN);
            float n[4], o[4];
#pragma unroll
            for (int e = 0; e < 4; ++e) n[e] = v[e] * rs * gk4[e];
#pragma unroll
            for (int e = 0; e < 4; ++e) o[e] = n[e] * cg[e] - ror8(n[e]) * sg[e];
            u32x2 w; w.x = pk2(o[0], o[1]); w.y = pk2(o[2], o[3]); *(u32x2*)(KB + kvrow * 256 + 4 * lane) = w;
            *(u32x2*)(VB + kvrow * 256 + 4 * lane) = zv;
            if (!lat) { *(f32x4*)(a->out + O_K + orow * 256 + 4 * lane) = (f32x4){n[0], n[1], n[2], n[3]};
                        *(f32x4*)(a->out + O_V + orow * 256 + 4 * lane) = (f32x4){lo_bf(zv.x), hi_bf(zv.x), lo_bf(zv.y), hi_bf(zv.y)}; } }
        float vn[3][4], nope[6];
#pragma unroll
        for (int j = 0; j < 3; ++j) { vn[j][0] = lo_bf(zc[j].x); vn[j][1] = hi_bf(zc[j].x); vn[j][2] = lo_bf(zc[j].y); vn[j][3] = hi_bf(zc[j].y);
            const float rs_ = rowsum16((vn[j][0] * vn[j][0] + vn[j][1] * vn[j][1]) + (vn[j][2] * vn[j][2] + vn[j][3] * vn[j][3]));
            nope[2 * j] = rlf(rs_, 0) + rlf(rs_, 16); nope[2 * j + 1] = rlf(rs_, 32) + rlf(rs_, 48); }
        float ta[4] = {lo_bf(zra.x), hi_bf(zra.x), lo_bf(zra.y), hi_bf(zra.y)}, tb[4] = {lo_bf(zrb.x), hi_bf(zrb.x), lo_bf(zrb.y), hi_bf(zrb.y)};
        const float tsa = rowsum16((ta[0] * ta[0] + ta[1] * ta[1]) + (ta[2] * ta[2] + ta[3] * ta[3])), tsb = rowsum16((tb[0] * tb[0] + tb[1] * tb[1]) + (tb[2] * tb[2] + tb[3] * tb[3]));
        float rsh[6];
        rsh[0] = rsqrtf((nope[0] + rlf(tsa, 0)) * (1.f / 192.f) + EPSN); rsh[1] = rsqrtf((nope[1] + rlf(tsa, 16)) * (1.f / 192.f) + EPSN);
        rsh[2] = rsqrtf((nope[2] + rlf(tsa, 32)) * (1.f / 192.f) + EPSN); rsh[3] = rsqrtf((nope[3] + rlf(tsa, 48)) * (1.f / 192.f) + EPSN);
        rsh[4] = rsqrtf((nope[4] + rlf(tsb, 0)) * (1.f / 192.f) + EPSN); rsh[5] = rsqrtf((nope[5] + rlf(tsb, 16)) * (1.f / 192.f) + EPSN);
#pragma unroll
        for (int j = 0; j < 3; ++j) { const float rs = hp ? rsh[2 * j + 1] : rsh[2 * j];
            u32x2 w; w.x = pk2(vn[j][0] * rs * gcn4[0], vn[j][1] * rs * gcn4[1]); w.y = pk2(vn[j][2] * rs * gcn4[2], vn[j][3] * rs * gcn4[3]);
            *(u32x2*)(QC + (size_t)r * 1152 + 192 * (2 * j + hp) + 4 * m) = w; }
        { const float rsa = ht == 0 ? rsh[0] : ht == 1 ? rsh[1] : ht == 2 ? rsh[2] : rsh[3]; const float rsb = ht == 0 ? rsh[4] : rsh[5];
          float na[4], nb[4], oa[4], ob[4];
#pragma unroll
          for (int e = 0; e < 4; ++e) { na[e] = ta[e] * rsa * gcr4[e]; nb[e] = tb[e] * rsb * gcr4[e]; }
#pragma unroll
          for (int e = 0; e < 4; ++e) { oa[e] = na[e] * cc[e] - swz4(na[e]) * sc[e]; ob[e] = nb[e] * cc[e] - swz4(nb[e]) * sc[e]; }
          u32x2 w; w.x = pk2(oa[0], oa[1]); w.y = pk2(oa[2], oa[3]); *(u32x2*)(QC + (size_t)r * 1152 + 192 * ht + 128 + 4 * mt) = w;
          if (lane < 32) { w.x = pk2(ob[0], ob[1]); w.y = pk2(ob[2], ob[3]); *(u32x2*)(QC + (size_t)r * 1152 + 192 * (4 + ht) + 128 + 4 * mt) = w; } }
        { float x[8];
          x[0] = lo_bf(raw.x); x[1] = hi_bf(raw.x); x[2] = lo_bf(raw.y); x[3] = hi_bf(raw.y); x[4] = lo_bf(raw.z); x[5] = hi_bf(raw.z); x[6] = lo_bf(raw.w); x[7] = hi_bf(raw.w);
          float sq = 0.f;
#pragma unroll
          for (int j = 0; j < 8; ++j) sq += x[j] * x[j];
          const float rs = rsqrtf(wave_sum(sq) * (1.f / 512.f) + EPSN);
          const f32x4 y0 = (f32x4){x[0], x[1], x[2], x[3]} * rs * gkv0, y1 = (f32x4){x[4], x[5], x[6], x[7]} * rs * gkv1;
          u32x4 w4; w4.x = pk2(y0.x, y0.y); w4.y = pk2(y0.z, y0.w); w4.z = pk2(y1.x, y1.y); w4.w = pk2(y1.z, y1.w); *(u32x4*)(CKVN + kvrow * 512 + lane * 8) = w4;
          if (!lat) { *(f32x4*)(a->out + O_CKV + orow * 512 + lane * 8) = y0; *(f32x4*)(a->out + O_CKV + orow * 512 + lane * 8 + 4) = y1; } }
        if (lane < 16) { const f32x4 kv = (f32x4){lo_bf(zkr.x), hi_bf(zkr.x), lo_bf(zkr.y), hi_bf(zkr.y)}; *(f32x4*)(KR + kvrow * 64 + 4 * lane) = kv; if (!lat) *(f32x4*)(a->out + O_KRO + orow * 64 + 4 * lane) = kv; }
    }
}

__device__ __forceinline__ float lcst(float v) { asm volatile("" : "+v"(v)); return v; }
__device__ __forceinline__ void sincos_acc(float x, float& s, float& c) {
    const float k = rintf(x * 0.636619772367581343f);
    float r = fmaf(-k, 1.5703125f, x); r = fmaf(-k, 4.837512969970703125e-4f, r); r = fmaf(-k, 7.54978995489188e-8f, r);
    const float r2 = r * r;
    const float sr = fmaf(r * r2, fmaf(r2, fmaf(r2, lcst(-1.9515295891e-4f), lcst(8.3321608736e-3f)), lcst(-1.6666654611e-1f)), r);
    const float cr = fmaf(r2 * r2, fmaf(r2, fmaf(r2, lcst(2.443315711809948e-5f), lcst(-1.388731625493765e-3f)), lcst(4.166664568298827e-2f)), fmaf(r2, -0.5f, 1.0f));
    const int q = ((int)k) & 3;
    s = (q == 0) ? sr : (q == 1) ? cr : (q == 2) ? -sr : -cr;
    c = (q == 0) ? cr : (q == 1) ? -sr : (q == 2) ? -cr : sr;
}
constexpr int S5_HROW = 272;
constexpr int S5_BUROW = 528;
constexpr int S5_WLDS = 16 * S5_BUROW + 16 * S5_HROW;
__device__ __forceinline__ void s5_item(AP a, int l, int seq, int dir, int g, LAS unsigned char* wl, int lane) {
    const bool lat = seq >= 32; const int T = lat ? 1024 : 256; const int row0 = lat ? NCTXR + (seq - 32) * 1024 : seq * 256;
    const int pidx = (l * 2 + dir) * 32 + g;
    const bf16_t* Z = (const bf16_t*)(a->ws + WS_Z);
    float* Yd = (float*)(a->ws + (dir ? WS_YB : WS_YF));
    float lbr, lbi, cr, ci;
    { const float lr = a->in[21][pidx * 64 + lane], li = a->in[22][pidx * 64 + lane]; const float dt = expf(a->in[23][pidx]);
      const float ang = li * dt; float sn, cs, sh, ch; sincos_acc(ang, sn, cs); sincos_acc(0.5f * ang, sh, ch);
      const float em1 = expm1f(lr * dt), mag = em1 + 1.f;
      lbr = mag * cs; lbi = mag * sn;
      const float nr = em1 - 2.f * mag * sh * sh, ni = lbi, den = lr * lr + li * li; cr = (nr * lr + ni * li) / den; ci = (ni * lr - nr * li) / den; }
    bf16x8 ahi[8];
    { const int ri = lane & 1, cb = 8 * ((lane >> 4) & 1); const bool act = lane < 32;
#pragma unroll
      for (int m = 0; m < 8; ++m) { const int pm = 8 * m + ((lane & 15) >> 1);
          const float crm = __shfl(cr, pm), cim = __shfl(ci, pm);
          const f32x4* bre = (const f32x4*)(a->in[24] + ((size_t)pidx * 64 + pm) * 16 + cb); const f32x4* bim = (const f32x4*)(a->in[25] + ((size_t)pidx * 64 + pm) * 16 + cb);
          float v[8];
#pragma unroll
          for (int j = 0; j < 2; ++j) { const f32x4 br = bre[j], bi = bim[j];
#pragma unroll
              for (int e = 0; e < 4; ++e) v[j * 4 + e] = act ? (ri ? crm * bi[e] + cim * br[e] : crm * br[e] - cim * bi[e]) : 0.f; }
          u32x4 wh; wh.x = pk2(v[0], v[1]); wh.y = pk2(v[2], v[3]); wh.z = pk2(v[4], v[5]); wh.w = pk2(v[6], v[7]);
          ahi[m] = __builtin_bit_cast(bf16x8, wh); } }
    bf16x8 cf[4];
    { const int cc = lane & 15;
#pragma unroll
      for (int kb = 0; kb < 4; ++kb) { const int p0 = 16 * kb + 4 * (lane >> 4);
          const f32x4 c_r = *(const f32x4*)(a->in[26] + ((size_t)pidx * 16 + cc) * 64 + p0), c_i = *(const f32x4*)(a->in[27] + ((size_t)pidx * 16 + cc) * 64 + p0);
          u32x4 w; w.x = pk2(c_r.x, -c_i.x); w.y = pk2(c_r.y, -c_i.y); w.z = pk2(c_r.z, -c_i.z); w.w = pk2(c_r.w, -c_i.w); cf[kb] = __builtin_bit_cast(bf16x8, w); } }
    float hr = 0.f, hi = 0.f;
    if (lat) { const f32x2 h0 = *(const f32x2*)(a->in[6] + (((((size_t)(seq - 32) * 2 + l) * 2 + dir) * 32 + g) * 64 + lane) * 2); hr = h0.x; hi = h0.y; }
    LAS unsigned char* BU = wl; LAS unsigned char* H = wl + 16 * S5_BUROW;
    const int ut = lane & 15, uh = (lane >> 4) & 1;
    auto urow = [&](int n) { return (size_t)(row0 + (dir ? T - 1 - n : n)); };
    u32x4 ureg = (u32x4){0u, 0u, 0u, 0u}, unext = (u32x4){0u, 0u, 0u, 0u};
    if (lane < 32) ureg = *(const u32x4*)(Z + urow(ut) * INWP + ZU + g * 16 + uh * 8);
    const int nch = T / 16;
    for (int ci_ = 0; ci_ < nch; ++ci_) {
        if (ci_ + 1 < nch && lane < 32) unext = *(const u32x4*)(Z + urow(16 * (ci_ + 1) + ut) * INWP + ZU + g * 16 + uh * 8);
        const bf16x8 ub = __builtin_bit_cast(bf16x8, ureg);
#pragma unroll
        for (int m = 0; m < 8; ++m) { const f32x4 d = __builtin_amdgcn_mfma_f32_16x16x32_bf16(ahi[m], ub, (f32x4){0.f, 0.f, 0.f, 0.f}, 0, 0, 0);
            *(LAS f32x4*)(BU + (lane & 15) * S5_BUROW + (16 * m + 4 * (lane >> 4)) * 4) = d; }
        asm volatile("" ::: "memory");
#pragma unroll
        for (int s = 0; s < 16; ++s) {
            const f32x2 b = *(const LAS f32x2*)(BU + s * S5_BUROW + lane * 8);
            const float nr = lbr * hr - lbi * hi + b.x, ni = lbr * hi + lbi * hr + b.y; hr = nr; hi = ni;
            *(LAS unsigned*)(H + s * S5_HROW + lane * 4) = pk2(hr, hi);
        }
        asm volatile("" ::: "memory");
        f32x4 acc = (f32x4){0.f, 0.f, 0.f, 0.f};
#pragma unroll
        for (int kb = 0; kb < 4; ++kb) { const bf16x8 hb = *(const LAS bf16x8*)(H + (lane & 15) * S5_HROW + (16 * kb + 4 * (lane >> 4)) * 4);
            acc = __builtin_amdgcn_mfma_f32_16x16x32_bf16(cf[kb], hb, acc, 0, 0, 0); }
        *(f32x4*)(Yd + ((size_t)g * NTOK + urow(16 * ci_ + (lane & 15))) * 16 + 4 * (lane >> 4)) = acc;
        asm volatile("" ::: "memory");
        ureg = unext;
    }
    if (!lat) { *(f32x2*)(a->out + O_SSM + (((((size_t)seq * 2 + l) * 2 + dir) * 32 + g) * 64 + lane) * 2) = (f32x2){hr, hi}; }
}
__device__ __forceinline__ void s5_phase(AP a, const Ctx& c, int l, LAS unsigned char* lds) {
    LAS unsigned char* wl = lds + c.wave * S5_WLDS;
    const int slot = c.wave * c.G + c.bx, nslots = NWAVES * c.G;
    if (nslots > 512 + 64) {
        if (slot < 512) { const int it = slot; s5_item(a, l, 32 + it / 64, (it % 64) >> 5, it & 31, wl, c.lane); }
        else { for (int j = slot - 512; j < 2048; j += nslots - 512) s5_item(a, l, j / 64, (j % 64) >> 5, j & 31, wl, c.lane); }
    } else {
        for (int it = slot; it < 2560; it += nslots) { int seq, rem; if (it < 512) { seq = 32 + it / 64; rem = it % 64; } else { const int j = it - 512; seq = j / 64; rem = j % 64; }
            s5_item(a, l, seq, rem >> 5, rem & 31, wl, c.lane); }
    }
}

__device__ __forceinline__ void knorm_combine(AP a, const Ctx& c, int l) {
    const bf16_t* KVRAW = (const bf16_t*)(a->ws + WS_KVRAW); const float* KR = (const float*)(a->ws + WS_KR); bf16_t* KC = (bf16_t*)(a->ws + WS_KC);
    const int lane = c.lane;
    const int halfc = (lane >> 4) & 1; const bool isx1c = (lane & 8) == 0; const int ibc = 2 * (lane & 7);
    const float inv64_0 = __builtin_amdgcn_exp2f(-(float)ibc * (L2_10000 / 16.f)), inv64_1 = __builtin_amdgcn_exp2f(-(float)(ibc + 1) * (L2_10000 / 16.f));
    const f32x2 gn = *(const f32x2*)(a->in[18] + l * 192 + 2 * lane);
    const f32x2 gr = lane < 32 ? *(const f32x2*)(a->in[18] + l * 192 + 128 + 2 * lane) : (f32x2){0.f, 0.f};
    unsigned kkn[6]; f32x2 krn = (f32x2){0.f, 0.f};
    if (c.gw < KVROWS) { const bf16_t* kn = KVRAW + (size_t)c.gw * 1536;
#pragma unroll
        for (int hh = 0; hh < 6; ++hh) kkn[hh] = *(const unsigned*)(kn + hh * 128 + 2 * lane);
        if (lane < 32) krn = *(const f32x2*)(KR + (size_t)c.gw * 64 + 2 * lane); }
    for (int r = c.gw; r < KVROWS; r += c.NGW) {
        bool isnew = false; int t = 0;
        if (r >= 8192) { const int q = (r - 8192) % 1536; if (q >= 512) { isnew = true; t = q - 512; } }
        unsigned kk[6]; f32x2 kr2 = krn;
#pragma unroll
        for (int hh = 0; hh < 6; ++hh) kk[hh] = kkn[hh];
        if (r + c.NGW < KVROWS) { const bf16_t* kn = KVRAW + (size_t)(r + c.NGW) * 1536;
#pragma unroll
            for (int hh = 0; hh < 6; ++hh) kkn[hh] = *(const unsigned*)(kn + hh * 128 + 2 * lane);
            if (lane < 32) krn = *(const f32x2*)(KR + (size_t)(r + c.NGW) * 64 + 2 * lane); }
        asm volatile("" ::: "memory");
        float c60 = 1.f, s60 = 0.f, c61 = 1.f, s61 = 0.f;
        if (isnew) { const float pc = halfc ? (float)(t & 63) : (float)(t >> 6); c60 = __cosf(pc * inv64_0); s60 = __sinf(pc * inv64_0); c61 = __cosf(pc * inv64_1); s61 = __sinf(pc * inv64_1); }
        if (!isx1c) { s60 = -s60; s61 = -s61; }
        const float sskr = wave_sum(kr2.x * kr2.x + kr2.y * kr2.y);
#pragma unroll
        for (int hh = 0; hh < 6; ++hh) { const float va = lo_bf(kk[hh]), vb = hi_bf(kk[hh]);
            const float rs = rsqrtf((wave_sum(va * va + vb * vb) + sskr) * (1.f / 192.f) + EPSN);
            bf16_t* ko = KC + (size_t)r * 1152 + hh * 192;
            *(unsigned*)(ko + 2 * lane) = pk2(va * rs * gn.x, vb * rs * gn.y);
            const float n0 = kr2.x * rs * gr.x, n1 = kr2.y * rs * gr.y; const float p0 = swz8(n0), p1 = swz8(n1);
            if (lane < 32) *(unsigned*)(ko + 128 + 2 * lane) = pk2(n0 * c60 - p0 * s60, n1 * c61 - p1 * s61); }
    }
    const bf16_t* Z = (const bf16_t*)(a->ws + WS_Z); const float* YF = (const float*)(a->ws + WS_YF); const float* YB = (const float*)(a->ws + WS_YB); bf16_t* Y = (bf16_t*)(a->ws + WS_Y);
    const f32x4 d0 = *(const f32x4*)(a->in[28] + l * 512 + lane * 8), d1 = *(const f32x4*)(a->in[28] + l * 512 + lane * 8 + 4);
    for (int r = c.gw; r < NTOK; r += c.NGW) {
        const u32x4 raw = *(const u32x4*)(Z + (size_t)r * INWP + ZU + lane * 8);
        const f32x4 u0 = (f32x4){__builtin_bit_cast(float, raw.x << 16), __builtin_bit_cast(float, raw.x & 0xffff0000u), __builtin_bit_cast(float, raw.y << 16), __builtin_bit_cast(float, raw.y & 0xffff0000u)};
        const f32x4 u1 = (f32x4){__builtin_bit_cast(float, raw.z << 16), __builtin_bit_cast(float, raw.z & 0xffff0000u), __builtin_bit_cast(float, raw.w << 16), __builtin_bit_cast(float, raw.w & 0xffff0000u)};
        const size_t yo = ((size_t)(lane >> 1) * NTOK + r) * 16 + (lane & 1) * 8;
        const f32x4 f0 = *(const f32x4*)(YF + yo), f1 = *(const f32x4*)(YF + yo + 4);
        const f32x4 b0 = *(const f32x4*)(YB + yo), b1 = *(const f32x4*)(YB + yo + 4);
        const f32x4 y0 = d0 * u0 + f0 + b0, y1 = d1 * u1 + f1 + b1;
        u32x4 w; w.x = pk2(y0.x, y0.y); w.y = pk2(y0.z, y0.w); w.z = pk2(y1.x, y1.y); w.w = pk2(y1.z, y1.w); *(u32x4*)(Y + (size_t)r * 512 + lane * 8) = w;
    }
}

template <bool MLA>
__device__ __forceinline__ void attn_unit_run(AP a, int u, char* lds, const int tid) {
    int seq, h, qb;
    if (u < 192) { seq = 32 + u / 24; h = (u % 24) >> 2; qb = u & 3; } else { const int j = u - 192; seq = j / 6; h = j % 6; qb = 0; }
    const bool lat = seq >= 32;
    const size_t qrow = lat ? NCTXR + (size_t)(seq - 32) * 1024 + qb * 256 : (size_t)seq * 256;
    const size_t kvrow = lat ? 8192 + (size_t)(seq - 32) * 1536 : (size_t)seq * 256;
    const int nkeys = lat ? 1536 : 256;
    bf16_t* MIX = (bf16_t*)(a->ws + WS_MIX);
    if constexpr (!MLA) {
        const bf16_t* Q = (const bf16_t*)(a->ws + WS_QB) + qrow * 768 + h * 128;
        const bf16_t* K = (const bf16_t*)(a->ws + WS_KB) + kvrow * 256 + (h / 3) * 128;
        const bf16_t* V = (const bf16_t*)(a->ws + WS_VB) + kvrow * 256 + (h / 3) * 128;
        att::attn_body<128, 768, 256, 256>(Q, K, V, MIX + qrow * 2048 + 512 + h * 128, nkeys, lds, tid);
    } else {
        const bf16_t* Q = (const bf16_t*)(a->ws + WS_QC) + qrow * 1152 + h * 192;
        const bf16_t* K = (const bf16_t*)(a->ws + WS_KC) + kvrow * 1152 + h * 192;
        const bf16_t* V = (const bf16_t*)(a->ws + WS_KVRAW) + kvrow * 1536 + 768 + h * 128;
        att::attn_body<192, 1152, 1152, 1536>(Q, K, V, MIX + qrow * 2048 + 1280 + h * 128, nkeys, lds, tid);
    }
}
template <bool MLA>
__device__ __forceinline__ void attn_phase(AP a, const Ctx& c, char* lds) {
    const int bx = c.vc;
    int u0, du, nu;
    if (c.G == 256) { if (bx < 192) { u0 = bx; du = 1; nu = 1; } else { u0 = 192 + 3 * (bx - 192); du = 1; nu = 3; } }
    else { u0 = bx; du = c.G; nu = (384 - bx + c.G - 1) / c.G; }
#pragma unroll 1
    for (int k = 0; k < nu; ++k) attn_unit_run<MLA>(a, u0 + k * du, lds, c.tid);
}

__global__ void __launch_bounds__(NTHR, 2) fwd_megakernel(Args kargs_unused) {
    extern __shared__ __attribute__((aligned(16))) unsigned char lds_raw[];
    cg::grid_group grid = cg::this_grid();
    LAS unsigned char* lds = (LAS unsigned char*)lds_raw;
    Ctx c;
    AP a = (AP)__builtin_amdgcn_kernarg_segment_ptr();
    const int wave_id0 = __builtin_amdgcn_readfirstlane((int)threadIdx.x >> 6);
#define PHASE_BEGIN() do { int w_ = wave_id0; asm volatile("" : "+s"(w_)); int ln_; asm volatile("v_mbcnt_lo_u32_b32 %0, -1, 0\n\tv_mbcnt_hi_u32_b32 %0, -1, %0" : "=v"(ln_)); \
        int b_ = blockIdx.x; asm volatile("" : "+s"(b_)); int g_ = gridDim.x; asm volatile("" : "+s"(g_)); \
        c.tid = w_ * 64 + ln_; c.lane = ln_; c.wave = w_; c.G = g_; c.bx = b_; c.gw = b_ * NWAVES + w_; c.NGW = g_ * NWAVES; asm volatile("" : "+s"(a)); \
        c.xp = __builtin_amdgcn_readfirstlane((int)((volatile LAS unsigned*)(lds + 131072))[0]); c.xn = __builtin_amdgcn_readfirstlane((int)((volatile LAS unsigned*)(lds + 131072))[1]); \
        c.xr = __builtin_amdgcn_readfirstlane((int)((volatile LAS unsigned*)(lds + 131072))[2]); c.vc = c.xp + c.xr; } while (0)
#define GRID_SYNC() do { asm volatile("s_waitcnt vmcnt(0) lgkmcnt(0)" ::: "memory"); grid.sync(); \
        if (wave_id0 == 0) { __builtin_amdgcn_fence(__ATOMIC_ACQUIRE, "agent"); asm volatile("s_waitcnt vmcnt(0)" ::: "memory"); } \
        __syncthreads(); } while (0)
    unsigned nbar = 0u;
#define XB_SYNC() do { asm volatile("s_waitcnt vmcnt(0) lgkmcnt(0)" ::: "memory"); __syncthreads(); \
        if (threadIdx.x == 0) { volatile LAS unsigned* mz_ = (volatile LAS unsigned*)(lds + 131072); const unsigned x_ = mz_[4], nx_ = mz_[5], nloc_ = mz_[6]; \
            AP a2_ = a; asm volatile("" : "+s"(a2_)); unsigned* xb_ = (unsigned*)(a2_->ws + WS_XB); \
            const unsigned old_ = __hip_atomic_fetch_add(xb_ + 64u * x_, 1u, __ATOMIC_RELAXED, __HIP_MEMORY_SCOPE_AGENT); \
            if (old_ + 1u == (nbar + 1u) * nloc_) { \
                __builtin_amdgcn_fence(__ATOMIC_RELEASE, "agent"); asm volatile("s_waitcnt vmcnt(0)" ::: "memory"); \
                const unsigned og_ = __hip_atomic_fetch_add(xb_ + 2048, 1u, __ATOMIC_RELAXED, __HIP_MEMORY_SCOPE_AGENT); \
                if (og_ + 1u == (nbar + 1u) * nx_) (void)__hip_atomic_fetch_add(xb_ + 2112, 1u, __ATOMIC_RELAXED, __HIP_MEMORY_SCOPE_AGENT); \
                else while (__hip_atomic_load(xb_ + 2112, __ATOMIC_RELAXED, __HIP_MEMORY_SCOPE_AGENT) == nbar) __builtin_amdgcn_s_sleep(1); \
                __builtin_amdgcn_fence(__ATOMIC_ACQUIRE, "agent"); \
                (void)__hip_atomic_fetch_add(xb_ + 1024u + 64u * x_, 1u, __ATOMIC_RELAXED, __HIP_MEMORY_SCOPE_AGENT); asm volatile("s_waitcnt vmcnt(0)" ::: "memory"); \
            } else { \
                while (__hip_atomic_load(xb_ + 1024u + 64u * x_, __ATOMIC_RELAXED, __HIP_MEMORY_SCOPE_AGENT) == nbar) __builtin_amdgcn_s_sleep(1); \
                __builtin_amdgcn_fence(__ATOMIC_ACQUIRE, "agent"); asm volatile("s_waitcnt vmcnt(0)" ::: "memory"); } } \
        nbar += 1u; __syncthreads(); } while (0)
    PHASE_BEGIN();

#ifndef PH
#define PH 0xFFFF
#endif
#if PH & 1
    if (blockIdx.x == 0 && threadIdx.x < 16) ((unsigned*)(a->ws + WS_CEN))[threadIdx.x] = 0u;
    if (blockIdx.x == 0) for (int i = threadIdx.x; i < 2176; i += NTHR) ((unsigned*)(a->ws + WS_XB))[i] = 0u;
    phase0(a, c, lds);
#endif
    GRID_SYNC(); PHASE_BEGIN();
    { volatile LAS unsigned* misc = (volatile LAS unsigned*)(lds + 131072);
      if (c.tid == 0) { unsigned* cen = (unsigned*)(a->ws + WS_CEN); const unsigned x = (unsigned)__builtin_amdgcn_s_getreg((3 << 11) | 20) & 0xFu;
          misc[2] = x; misc[3] = __hip_atomic_fetch_add(cen + x, 1u, __ATOMIC_RELAXED, __HIP_MEMORY_SCOPE_AGENT); }
      GRID_SYNC();
      if (threadIdx.x == 0) { unsigned* cen = (unsigned*)(a->ws + WS_CEN); const unsigned x = misc[2], rank = misc[3]; unsigned pre = 0u, mine = 1u, tot = 0u;
          for (unsigned j = 0; j < 16; ++j) { const unsigned v = __hip_atomic_load(cen + j, __ATOMIC_RELAXED, __HIP_MEMORY_SCOPE_AGENT); tot += v; if (j < x) pre += v; if (j == x) mine = v; }
          if (tot != gridDim.x || rank >= mine) { pre = blockIdx.x; mine = 1u; }
          unsigned nxp = 0u; for (unsigned j = 0; j < 16; ++j) nxp += __hip_atomic_load(cen + j, __ATOMIC_RELAXED, __HIP_MEMORY_SCOPE_AGENT) ? 1u : 0u;
          const bool bad = (tot != gridDim.x || rank >= mine);
          misc[0] = pre; misc[1] = mine; misc[2] = bad ? 0u : rank; misc[4] = x; misc[5] = bad ? 0u : nxp; misc[6] = bad ? 1u : mine; }
      __syncthreads(); PHASE_BEGIN(); }

    const bool use_xb = __builtin_amdgcn_readfirstlane((int)((volatile LAS unsigned*)(lds + 131072))[5]) != 0;
#define SEAM() do { if (use_xb) XB_SYNC(); else GRID_SYNC(); } while (0)
#pragma unroll
    for (int l = 0; l < 2; ++l) {
        const bool first = (l == 0);
#define WLP (a->ws + WS_W + (size_t)l * WL_SIZE)
#if PH & 2
        phase_norm(a, c, l, 0, first);
#endif
        SEAM(); PHASE_BEGIN();
#if PH & 4
        { pg8::Gemm g{(const bf16_t*)(a->ws + WS_HN), (const bf16_t*)(WLP + WL_IN), NTOK, INWP, DM}; pg8::StaticOrder S; S.init(NTOK, INWP, c.G, c.xp, c.xn, c.xr);
          pg8::EpiBf16<0> E{(bf16_t*)(a->ws + WS_Z), INWP};
          pg8::gemm_phase<pg8::EpiBf16<0>, pg8::StaticOrder, true, true>(lds, g, S, E, c.tid); }
        SEAM(); PHASE_BEGIN();
#endif
#if PH & 8
        s5_phase(a, c, l, lds);
#endif
        PHASE_BEGIN();
#if PH & 16
        zpost_rows(a, c, l);
#endif
        SEAM(); PHASE_BEGIN();
#if PH & 32
        { pg8::Gemm g{(const bf16_t*)(a->ws + WS_CKVN), (const bf16_t*)(WLP + WL_UKV), KVROWS, 1536, 512}; pg8::StaticOrder S; S.init(KVROWS, 1536, c.G, c.xp, c.xn, c.xr);
          pg8::EpiBf16<0> E{(bf16_t*)(a->ws + WS_KVRAW), 1536};
          pg8::gemm_phase<pg8::EpiBf16<0>, pg8::StaticOrder, true, true>(lds, g, S, E, c.tid); }
#endif
        __syncthreads(); PHASE_BEGIN();
#if PH & 64
        attn_phase<false>(a, c, (char*)lds_raw);
#endif
        SEAM(); PHASE_BEGIN();
#if PH & 128
        knorm_combine(a, c, l);
#endif
        SEAM(); PHASE_BEGIN();
#if PH & 256
        attn_phase<true>(a, c, (char*)lds_raw);
#endif
        __syncthreads(); PHASE_BEGIN();
#if PH & 512
        { pg8::Gemm g{(const bf16_t*)(a->ws + WS_Y), (const bf16_t*)(WLP + WL_GLU), NTOK, 1024, 512}; pg8::StaticOrder S; S.init(NTOK, 1024, c.G, c.xp, c.xn, c.xr);
          pg8::EpiGlu E{(bf16_t*)(a->ws + WS_MIX), DM};
          pg8::gemm_phase<pg8::EpiGlu, pg8::StaticOrder, true, true>(lds, g, S, E, c.tid); }
        SEAM(); PHASE_BEGIN();
#endif
#if PH & 1024
        { pg8::Gemm g{(const bf16_t*)(a->ws + WS_MIX), (const bf16_t*)(WLP + WL_OUT), NTOK, DM, DM}; pg8::StaticOrder S; S.init(NTOK, DM, c.G, c.xp, c.xn, c.xr);
          pg8::EpiResGate E{first ? a->in[0] : a->out, first ? a->in[1] : a->out + (size_t)NCTXR * DM, a->out, (const float*)(a->ws + WS_MOD) + (size_t)l * 9 * 12288 + 2 * DM};
          pg8::gemm_phase<pg8::EpiResGate, pg8::StaticOrder, true, true>(lds, g, S, E, c.tid); }
        SEAM(); PHASE_BEGIN();
#endif
#if PH & 2048
        phase_norm(a, c, l, 1, false);
#endif
        SEAM(); PHASE_BEGIN();
#if PH & 4096
        { pg8::Gemm g{(const bf16_t*)(a->ws + WS_HN), (const bf16_t*)(WLP + WL_FF1), NTOK, DFF, DM}; pg8::StaticOrder S; S.init(NTOK, DFF, c.G, c.xp, c.xn, c.xr);
          pg8::EpiBf16<2> E{(bf16_t*)(a->ws + WS_HFF), DFF};
          pg8::gemm_phase<pg8::EpiBf16<2>, pg8::StaticOrder, true, true>(lds, g, S, E, c.tid); }
        SEAM(); PHASE_BEGIN();
#endif
#if PH & 8192
        { pg8::Gemm g{(const bf16_t*)(a->ws + WS_HFF), (const bf16_t*)(WLP + WL_FF2), NTOK, DM, DFF}; pg8::StaticOrder S; S.init(NTOK, DM, c.G, c.xp, c.xn, c.xr);
          pg8::EpiResGate E{a->out, a->out + (size_t)NCTXR * DM, a->out, (const float*)(a->ws + WS_MOD) + (size_t)l * 9 * 12288 + 5 * DM};
          pg8::gemm_phase<pg8::EpiResGate, pg8::StaticOrder, true, true>(lds, g, S, E, c.tid); }
#endif
        if (l == 0) { SEAM(); PHASE_BEGIN(); }
    }
}

extern "C" void kernel_launch(void* const* d_in, const int* in_sizes, int n_in, void* d_out, int out_size, void* d_ws, size_t ws_size, hipStream_t stream) {
    static int grid_blocks = 0;
    if (grid_blocks == 0) {
        if (n_in != 33 || ws_size < WS_END) { fprintf(stderr, "kernel_launch: unexpected n_in %d / ws_size %zu (need %zu)\n", n_in, ws_size, (size_t)WS_END); grid_blocks = -1; return; }
        int dev = 0, cus = 0, per_cu = 0;
        hipGetDevice(&dev);
        hipDeviceGetAttribute(&cus, hipDeviceAttributeMultiprocessorCount, dev);
        if (hipFuncSetAttribute((const void*)fwd_megakernel, hipFuncAttributeMaxDynamicSharedMemorySize, LDS_BYTES) != hipSuccess) { fprintf(stderr, "kernel_launch: hipFuncSetAttribute failed\n"); grid_blocks = -1; return; }
        hipOccupancyMaxActiveBlocksPerMultiprocessor(&per_cu, (const void*)fwd_megakernel, NTHR, LDS_BYTES);
        if (per_cu < 1) per_cu = 1;
        grid_blocks = cus * per_cu;
        (void)hipGetLastError();
    }
    if (grid_blocks < 0) return;
    Args a{};
    for (int i = 0; i < 33; ++i) a.in[i] = (const float*)d_in[i];
    a.out = (float*)d_out; a.ws = (unsigned char*)d_ws;
    void* args[] = {&a};
    hipError_t e = hipLaunchCooperativeKernel((const void*)fwd_megakernel, dim3(grid_blocks), dim3(NTHR), args, LDS_BYTES, stream);
    if (e != hipSuccess) fprintf(stderr, "cooperative launch failed: %s (grid %d)\n", hipGetErrorString(e), grid_blocks);
}
```
